# Optimizing an MI355X kernel written in HIP

```python
import math
import jax, jax.numpy as jnp
from jax import lax
import numpy as np

D_MODEL = 1024
BATCH = 8
SEQ = 4096
DEPTH = 4

N_A = DEPTH // 2
N_B = DEPTH - N_A
N_VRES = max(N_A - 1, 0)
RWKV_HEAD = 64
RWKV_HEADS = D_MODEL // RWKV_HEAD
DECAY_LORA = 64
AAA_LORA = 64
MV_LORA = 32
GATE_LORA = 160
GN_EPS = 64e-5
DIFF_HEAD = 64
DIFF_HEADS = D_MODEL // (2 * DIFF_HEAD)
QK_WIDTH = DIFF_HEADS * 2 * DIFF_HEAD
V_WIDTH = DIFF_HEADS * 2 * DIFF_HEAD
ROT_DIM = DIFF_HEAD // 4
ROPE_THETA = 500000.0
Q_BLOCK = 128
D_FF = ((8 * D_MODEL // 3 + 127) // 128) * 128
CONV_W = 3
NORM_EPS = 1e-6

kernel_name = "yoco_rwkv7_diffattn_convglu_adaln"


def rms_norm(x, g):
    xf = x.astype(jnp.float32)
    y = xf * lax.rsqrt(jnp.mean(xf * xf, axis=-1, keepdims=True) + NORM_EPS)
    return (y * g.astype(jnp.float32)).astype(x.dtype)


def modulate(h, shift, scale):
    return h * (1.0 + scale[:, None, :]) + shift[:, None, :]


def rope_tables(seq):
    pos = jnp.arange(seq, dtype=jnp.float32)
    inv = ROPE_THETA ** (-jnp.arange(0, ROT_DIM, 2, dtype=jnp.float32) / ROT_DIM)
    ang = pos[:, None] * inv[None, :]
    return jnp.cos(ang), jnp.sin(ang)


def partial_rope(t, cos, sin):
    half = ROT_DIM // 2
    cs = cos[None, :, None, None, :].astype(t.dtype)
    sn = sin[None, :, None, None, :].astype(t.dtype)
    x1 = t[..., :half]
    x2 = t[..., half:ROT_DIM]
    return jnp.concatenate([x1 * cs - x2 * sn, x2 * cs + x1 * sn, t[..., ROT_DIM:]], axis=-1)


def conv_glu_ffn(h, w_up, conv_w, conv_b, w_down):
    s = h.shape[1]
    u = h @ w_up
    up = jnp.pad(u, ((0, 0), (CONV_W - 1, 0), (0, 0)))
    u = conv_b + conv_w[0] * up[:, 0:s]
    for j in range(1, CONV_W):
        u = u + conv_w[j] * up[:, j:j + s]
    gate, val = jnp.split(u, 2, axis=-1)
    return (jax.nn.silu(gate) * val) @ w_down


def wkv7_scan(r, w, k, v, a_in, b_in):
    bsz, _, nh, n = r.shape

    def step(state, inp):
        rt, wt, kt, vt, at, bt = inp
        sa = jnp.einsum('bhvk,bhk->bhv', state, at)
        state = state * wt[:, :, None, :] + sa[..., None] * bt[:, :, None, :] + vt[..., None] * kt[:, :, None, :]
        y = jnp.einsum('bhvk,bhk->bhv', state, rt)
        return state, y

    xs = (jnp.moveaxis(r, 1, 0), jnp.moveaxis(w, 1, 0), jnp.moveaxis(k, 1, 0),
          jnp.moveaxis(v, 1, 0), jnp.moveaxis(a_in, 1, 0), jnp.moveaxis(b_in, 1, 0))
    s0 = jnp.zeros((bsz, nh, n, n), jnp.float32)
    _, ys = lax.scan(step, s0, xs)
    return jnp.moveaxis(ys, 0, 1)


def rwkv7_time_mix(h, v_first, vres, mu, w_rkv, w0, w1, w2, a0, a1, a2, g1, g2, k_k, k_a, r_k, ln_w, ln_b, w_o):
    bsz, s, d = h.shape
    xx = jnp.pad(h, ((0, 0), (1, 0), (0, 0)))[:, :-1] - h
    xr = h + xx * mu[0]
    xw = h + xx * mu[1]
    xk = h + xx * mu[2]
    xv = h + xx * mu[3]
    xa = h + xx * mu[4]
    xg = h + xx * mu[5]
    r = xr @ w_rkv[0]
    k = xk @ w_rkv[1]
    v = xv @ w_rkv[2]
    w = -jax.nn.softplus(-(w0 + jnp.tanh(xw @ w1) @ w2)) - 0.5
    if vres is None:
        v_first = v
    else:
        v0, v1, v2 = vres
        v = v + (v_first - v) * jax.nn.sigmoid(v0 + (xv @ v1) @ v2)
    a = jax.nn.sigmoid(a0 + (xa @ a1) @ a2)
    g = jax.nn.sigmoid(xg @ g1) @ g2

    def heads(t):
        return t.reshape(bsz, s, RWKV_HEADS, RWKV_HEAD).astype(jnp.float32)

    kk = heads(k * k_k)
    kk = kk / jnp.maximum(jnp.sqrt(jnp.sum(kk * kk, axis=-1, keepdims=True)), 1e-12)
    k = k * (1.0 + (a - 1.0) * k_a)
    rh, kh, vh, ah = heads(r), heads(k), heads(v), heads(a)
    decay = jnp.exp(-jnp.exp(heads(w)))
    o = wkv7_scan(rh, decay, kh, vh, -kk, kk * ah)
    mean = jnp.mean(o, axis=-1, keepdims=True)
    var = jnp.mean(jnp.square(o - mean), axis=-1, keepdims=True)
    o = ((o - mean) * lax.rsqrt(var + GN_EPS)).reshape(bsz, s, d) * ln_w + ln_b
    bonus = jnp.sum(rh * kh * r_k.astype(jnp.float32), axis=-1, keepdims=True) * vh
    o = o + bonus.reshape(bsz, s, d)
    return (o * g).astype(h.dtype) @ w_o, v_first


def diff_attention(h, k_sh, v_sh, cos, sin, w_q, lam_vecs, subln, w_o, lam_init):
    bsz, s, d = h.shape
    q = (h @ w_q).reshape(bsz, s, DIFF_HEADS, 2, DIFF_HEAD)
    q = partial_rope(q, cos, sin) * (DIFF_HEAD ** -0.5)
    lv = lam_vecs.astype(jnp.float32)
    lam = jnp.exp(jnp.sum(lv[0] * lv[1])) - jnp.exp(jnp.sum(lv[2] * lv[3])) + lam_init
    nqb = s // Q_BLOCK
    qb = q.reshape(bsz, nqb, Q_BLOCK, DIFF_HEADS, 2, DIFF_HEAD).transpose(1, 0, 2, 3, 4, 5)
    kpos = jnp.arange(s)

    def block(args):
        qblk, bi = args
        sc = jnp.einsum('bqhcd,bkhcd->bhcqk', qblk, k_sh, preferred_element_type=jnp.float32)
        qpos = bi * Q_BLOCK + jnp.arange(Q_BLOCK)
        mask = kpos[None, :] <= qpos[:, None]
        sc = jnp.where(mask, sc, -jnp.inf)
        p = jax.nn.softmax(sc, axis=-1)
        attn = p[:, :, 0] - lam * p[:, :, 1]
        return jnp.einsum('bhqk,bkhe->bqhe', attn.astype(v_sh.dtype), v_sh)

    o = lax.map(block, (qb, jnp.arange(nqb)))
    o = o.transpose(1, 0, 2, 3, 4).reshape(bsz, s, DIFF_HEADS, 2 * DIFF_HEAD)
    o = rms_norm(o, subln) * (1.0 - lam_init)
    return o.reshape(bsz, s, d) @ w_o


def setup_inputs(seed: int = 0) -> dict:
    key = jax.random.key(seed)
    ks = iter(jax.random.split(key, 40))
    D = D_MODEL
    F2 = 2 * D_FF

    def nrm(shape, scale):
        return jax.random.normal(next(ks), shape, jnp.float32) * scale

    x = nrm((BATCH, SEQ, D), 1.0)
    c = nrm((BATCH, D), 1.0)
    ada_w = nrm((DEPTH, D, 6 * D), 0.5 * D ** -0.5)
    ada_b = nrm((DEPTH, 6 * D), 0.02)
    norm1 = 1.0 + nrm((DEPTH, D), 0.02)
    norm2 = 1.0 + nrm((DEPTH, D), 0.02)
    final_norm = 1.0 + nrm((D,), 0.02)
    a_mu = jax.random.uniform(next(ks), (N_A, 6, D), jnp.float32, 0.0, 1.0)
    a_w_rkv = nrm((N_A, 3, D, D), D ** -0.5)
    a_w0 = jax.random.uniform(next(ks), (N_A, D), jnp.float32, -2.5, 0.5)
    a_w1 = nrm((N_A, D, DECAY_LORA), D ** -0.5)
    a_w2 = nrm((N_A, DECAY_LORA, D), 0.3 * DECAY_LORA ** -0.5)
    a_a0 = nrm((N_A, D), 0.5)
    a_a1 = nrm((N_A, D, AAA_LORA), D ** -0.5)
    a_a2 = nrm((N_A, AAA_LORA, D), 0.3 * AAA_LORA ** -0.5)
    a_v0 = nrm((N_VRES, D), 0.5)
    a_v1 = nrm((N_VRES, D, MV_LORA), D ** -0.5)
    a_v2 = nrm((N_VRES, MV_LORA, D), 0.3 * MV_LORA ** -0.5)
    a_g1 = nrm((N_A, D, GATE_LORA), D ** -0.5)
    a_g2 = nrm((N_A, GATE_LORA, D), GATE_LORA ** -0.5)
    a_k_k = 0.85 + nrm((N_A, D), 0.1)
    a_k_a = 1.0 + nrm((N_A, D), 0.1)
    a_r_k = nrm((N_A, RWKV_HEADS, RWKV_HEAD), 0.1)
    a_ln_w = 1.0 + nrm((N_A, D), 0.02)
    a_ln_b = nrm((N_A, D), 0.02)
    a_w_o = nrm((N_A, D, D), D ** -0.5)
    kv_norm = 1.0 + nrm((D,), 0.02)
    w_kv = nrm((D, QK_WIDTH + V_WIDTH), D ** -0.5)
    b_w_q = nrm((N_B, D, QK_WIDTH), D ** -0.5)
    b_lam = nrm((N_B, 4, DIFF_HEAD), 0.1)
    b_subln = 1.0 + nrm((N_B, 2 * DIFF_HEAD), 0.02)
    b_w_o = nrm((N_B, V_WIDTH, D), V_WIDTH ** -0.5)
    ffn_w_up = nrm((DEPTH, D, F2), D ** -0.5)
    ffn_conv_w = nrm((DEPTH, CONV_W, F2), CONV_W ** -0.5)
    ffn_conv_b = nrm((DEPTH, F2), 0.02)
    ffn_w_down = nrm((DEPTH, D_FF, D), D_FF ** -0.5)
    return {"x": x, "c": c, "ada_w": ada_w, "ada_b": ada_b, "norm1": norm1, "norm2": norm2,
            "final_norm": final_norm, "a_mu": a_mu, "a_w_rkv": a_w_rkv, "a_w0": a_w0, "a_w1": a_w1,
            "a_w2": a_w2, "a_a0": a_a0, "a_a1": a_a1, "a_a2": a_a2, "a_v0": a_v0, "a_v1": a_v1,
            "a_v2": a_v2, "a_g1": a_g1, "a_g2": a_g2, "a_k_k": a_k_k, "a_k_a": a_k_a, "a_r_k": a_r_k,
            "a_ln_w": a_ln_w, "a_ln_b": a_ln_b, "a_w_o": a_w_o, "kv_norm": kv_norm, "w_kv": w_kv,
            "b_w_q": b_w_q, "b_lam": b_lam, "b_subln": b_subln, "b_w_o": b_w_o,
            "ffn_w_up": ffn_w_up, "ffn_conv_w": ffn_conv_w, "ffn_conv_b": ffn_conv_b,
            "ffn_w_down": ffn_w_down}


def reference(x, c, ada_w, ada_b, norm1, norm2, final_norm,
              a_mu, a_w_rkv, a_w0, a_w1, a_w2, a_a0, a_a1, a_a2, a_v0, a_v1, a_v2,
              a_g1, a_g2, a_k_k, a_k_a, a_r_k, a_ln_w, a_ln_b, a_w_o,
              kv_norm, w_kv, b_w_q, b_lam, b_subln, b_w_o,
              ffn_w_up, ffn_conv_w, ffn_conv_b, ffn_w_down):
    bsz, s, d = x.shape
    cos, sin = rope_tables(s)
    c_act = jax.nn.silu(c)
    v_first = None
    k_sh = None
    v_sh = None
    for l in range(DEPTH):
        mod = c_act @ ada_w[l] + ada_b[l]
        sh1, sc1, g1, sh2, sc2, g2 = jnp.split(mod, 6, axis=-1)
        h = modulate(rms_norm(x, norm1[l]), sh1, sc1)
        if l < N_A:
            vres = None if l == 0 else (a_v0[l - 1], a_v1[l - 1], a_v2[l - 1])
            y, v_first = rwkv7_time_mix(h, v_first, vres, a_mu[l], a_w_rkv[l], a_w0[l], a_w1[l], a_w2[l],
                                        a_a0[l], a_a1[l], a_a2[l], a_g1[l], a_g2[l], a_k_k[l], a_k_a[l],
                                        a_r_k[l], a_ln_w[l], a_ln_b[l], a_w_o[l])
        else:
            j = l - N_A
            if j == 0:
                kv = rms_norm(x, kv_norm) @ w_kv
                k_sh = partial_rope(kv[..., :QK_WIDTH].reshape(bsz, s, DIFF_HEADS, 2, DIFF_HEAD), cos, sin)
                v_sh = kv[..., QK_WIDTH:].reshape(bsz, s, DIFF_HEADS, 2 * DIFF_HEAD)
            lam_init = 0.8 - 0.6 * math.exp(-0.3 * l)
            y = diff_attention(h, k_sh, v_sh, cos, sin, b_w_q[j], b_lam[j], b_subln[j], b_w_o[j], lam_init)
        x = x + g1[:, None, :] * y
        h2 = modulate(rms_norm(x, norm2[l]), sh2, sc2)
        x = x + g2[:, None, :] * conv_glu_ffn(h2, ffn_w_up[l], ffn_conv_w[l], ffn_conv_b[l], ffn_w_down[l])
    return rms_norm(x, final_norm)
```

```cpp
#include <hip/hip_runtime.h>
#include <hip/hip_cooperative_groups.h>
#include <cstdio>
#include <cstdint>
namespace cg = cooperative_groups;
namespace pg8 {
#define PG8_LAS __attribute__((address_space(3)))
typedef unsigned short bf16_t;
typedef short bf16x8 __attribute__((ext_vector_type(8)));
typedef float f32x4 __attribute__((ext_vector_type(4)));
typedef unsigned u32x4 __attribute__((ext_vector_type(4)));
constexpr int BM = 256, BK = 64, HALF = 128, HTB = HALF * BK * 2  , STAGE_BYTES = 8 * HTB, NXCD = 8, WGM = 8;

__host__ __device__ __forceinline__ int lds_byte(int r, int c) { const int st = (r >> 4) * 2 + (c >> 5), rr = r & 15, cc = c & 31, ob = rr * 64 + cc * 2; return st * 1024 + (ob ^ (((ob >> 9) & 1) << 5)); }
__host__ __device__ __forceinline__ void stage_rc(int b, int& R, int& C) { const int st = b / 1024, sb = b % 1024, swz = sb ^ (((sb >> 9) & 1) << 5); R = (st >> 1) * 16 + swz / 64; C = (st & 1) * 32 + (swz % 64) / 2; }
__host__ __device__ __forceinline__ int perm32(int rho) { const int n = rho >> 4, i = rho & 15; return 8 * (i >> 2) + 4 * n + (i & 3); }

struct Unit { int pm, pn; };
struct Gemm { const char* A; const bf16_t* Bt; int K, lda; };

struct StaticOrder {
    int nM, nN, nwg, G, c;
    __host__ __device__ void init(int nM_, int nN_, int G_, int c_) { nM = nM_; nN = nN_; nwg = nM * nN; G = G_; c = c_; }
    __host__ __device__ bool next(int i, Unit& u) const {
        const long L = (long)i * G + c; if (L >= nwg) return false;
        int wgid = (int)L; { const int q = nwg / NXCD, r = nwg % NXCD, xcd = wgid % NXCD, off = wgid / NXCD; wgid = (xcd < r ? xcd * (q + 1) : r * (q + 1) + (xcd - r) * q) + off; }
        const int nig = WGM * nN, gid = wgid / nig, fm = gid * WGM, gsz = (nM - fm) < WGM ? (nM - fm) : WGM;
        u.pm = fm + ((wgid % nig) % gsz); u.pn = (wgid % nig) / gsz; return true;
    }
    __device__ __forceinline__ void a_ready(const Unit&) const {}
    __device__ __forceinline__ void done(const Unit&) const {}
};

__device__ __forceinline__ unsigned cvt_pk_bf16(float lo, float hi) { unsigned r; asm volatile("v_cvt_pk_bf16_f32 %0, %1, %2" : "=v"(r) : "v"(lo), "v"(hi)); return r; }
typedef float f32x2 __attribute__((ext_vector_type(2)));
__device__ __forceinline__ f32x2 gelu_pk(f32x2 v) {
    const f32x2 av = __builtin_elementwise_abs(v), d = av * 0.2316418882f + 1.0f;
    f32x2 t; t.x = __builtin_amdgcn_rcpf(d.x); t.y = __builtin_amdgcn_rcpf(d.y);
    f32x2 q = t * 0.5307027145f + (-0.7265760135f); q = q * t + 0.7107068705f; q = q * t + (-0.142248368f); q = q * t + 0.127414796f; q = q * t;
    const f32x2 s = (v * v) * (-0.72134752044f);
    f32x2 e; e.x = __builtin_amdgcn_exp2f(s.x); e.y = __builtin_amdgcn_exp2f(s.y);
    const f32x2 m = v * (q * e), r = v - m;
    f32x2 o; o.x = v.x < 0.f ? m.x : r.x; o.y = v.y < 0.f ? m.y : r.y; return o;
}

template <int ACT  > struct EpiBf16 {
    static constexpr bool PERM = true, AFTER_DRAIN = false; static_assert(ACT == 0 || ACT == 1, "EpiBf16: ACT is 0 (none) or 1 (gelu_pk)");
    bf16_t* O; int ldc; const float* bias; int split_cols; size_t split_stride; float scale0;
    __device__ __forceinline__ void operator()(const f32x4 (&acc)[2][2][4][2], const Unit& u, int wr, int wc, int fr, int fq) const {
        const int row0 = u.pm * BM + wr * 64 + fr; int colt = u.pn * BM; bf16_t* base = O;
        float sc = 1.f; if (split_cols) { const int t = colt / split_cols; base += (size_t)t * split_stride; colt -= t * split_cols; if (t == 0) sc = scale0; }
        const int col0 = colt + wc * 32 + 8 * fq, bcol0 = u.pn * BM + wc * 32 + 8 * fq;
        f32x4 bv[2][2];
#pragma unroll
        for (int bj = 0; bj < 2; ++bj)
#pragma unroll
            for (int n = 0; n < 2; ++n) bv[bj][n] = bias ? *(const f32x4*)(bias + bcol0 + bj * HALF + 4 * n) : (f32x4){0.f, 0.f, 0.f, 0.f};
#pragma unroll
        for (int ai = 0; ai < 2; ++ai)
#pragma unroll
            for (int m = 0; m < 4; ++m) { bf16_t* rowp = base + (size_t)(row0 + ai * HALF + m * 16) * ldc + col0;
#pragma unroll
                for (int bj = 0; bj < 2; ++bj) { f32x4 v0 = acc[ai][bj][m][0] + bv[bj][0], v1 = acc[ai][bj][m][1] + bv[bj][1];
                    if (ACT == 1) { f32x2 a = gelu_pk((f32x2){v0[0], v0[1]}), b = gelu_pk((f32x2){v0[2], v0[3]}), c = gelu_pk((f32x2){v1[0], v1[1]}), d = gelu_pk((f32x2){v1[2], v1[3]});
                        v0 = (f32x4){a.x, a.y, b.x, b.y}; v1 = (f32x4){c.x, c.y, d.x, d.y}; }
                    v0 = v0 * sc; v1 = v1 * sc; u32x4 w; w.x = cvt_pk_bf16(v0[0], v0[1]); w.y = cvt_pk_bf16(v0[2], v0[3]); w.z = cvt_pk_bf16(v1[0], v1[1]); w.w = cvt_pk_bf16(v1[2], v1[3]);
                    *(u32x4*)(rowp + bj * HALF) = w; } }
    }
};
template <class Epi, class Sched, bool ALIGN_EPI, bool SP2, int UPB  , bool HALO, bool WRAP>
__device__ __forceinline__ void gemm_phase(PG8_LAS unsigned char* lds, const Gemm g, const Sched& S, const Epi& E) {
    int tid_o_ = threadIdx.x; asm volatile("" : "+v"(tid_o_)); const int tid = tid_o_, wid = __builtin_amdgcn_readfirstlane(tid >> 6), lane = tid & 63, wr = wid >> 2, wc = wid & 3, fr = lane & 15, fq = lane >> 4;
    const int K = g.K, nt = K / BK;
    unsigned voffA[2], voffB[2];
#pragma unroll
    for (int i = 0; i < 2; ++i) { int R, C; stage_rc(tid * 16 + i * 8192, R, C); const int Rb = Epi::PERM ? ((R & ~31) + perm32(R & 31)) : R;
        const int Ra = HALO ? (R - 2 * (R >> 6)) : R; voffA[i] = (unsigned)(Ra * g.lda + C) * 2u; voffB[i] = (unsigned)(Rb * K + C) * 2u; }
    const size_t kstep = (size_t)(BK * 2);
    const size_t hstep = (size_t)HALF * K * 2;
    const size_t hstepA = (size_t)((HALO ? 124 : 128) * g.lda * 2);
#define PG8_KOFFA(t) ((long)(t) * (long)kstep + ((WRAP && (t) >= 16) ? -(long)(16 * 128 + 2048) : 0l))
#define PG8_APTR(pm) (UPB ? (g.A + (size_t)((pm) / (UPB ? UPB : 1)) * (size_t)(4104 * 2048) + (size_t)((pm) % (UPB ? UPB : 1)) * (size_t)((HALO ? 248 : 256) * 2048)) : (g.A + (size_t)(pm) * (size_t)(256 * 2) * (size_t)g.lda))
    const size_t tstep = 2 * hstep;
    const unsigned ldsw = (unsigned)wid * 1024u;
    const int aoff = lds_byte(wr * 64 + fr, fq * 8), boff = lds_byte(wc * 32 + fr, fq * 8);
#define PG8_SA(b, h) (((b) * 2 + (h)) * HTB)
#define PG8_SB(b, h) ((4 + (b) * 2 + (h)) * HTB)
#define PG8_STAGE(bufoff, gbase, voff) do { _Pragma("unroll") for (int _i = 0; _i < 2; ++_i) \
        __builtin_amdgcn_global_load_lds((const unsigned*)((const char*)(gbase) + (voff)[_i]), (PG8_LAS unsigned*)(lds + (bufoff) + ldsw + _i * 8192), 16, 0, 0); } while (0)
#define PG8_LDA(dst, b, h) do { _Pragma("unroll") for (int m = 0; m < 4; ++m) _Pragma("unroll") for (int k = 0; k < 2; ++k) dst[m][k] = *(const PG8_LAS bf16x8*)(lds + PG8_SA(b, h) + aoff + m * 2048 + k * 1024); } while (0)
#define PG8_LDB(dst, b, h) do { _Pragma("unroll") for (int n = 0; n < 2; ++n) _Pragma("unroll") for (int k = 0; k < 2; ++k) dst[n][k] = *(const PG8_LAS bf16x8*)(lds + PG8_SB(b, h) + boff + n * 2048 + k * 1024); } while (0)
#define PG8_MMA(ai, bj, At, Bt) do { __builtin_amdgcn_s_setprio(1); _Pragma("unroll") for (int m = 0; m < 4; ++m) _Pragma("unroll") for (int n = 0; n < 2; ++n) _Pragma("unroll") for (int k = 0; k < 2; ++k) \
        acc[ai][bj][m][n] = __builtin_amdgcn_mfma_f32_16x16x32_bf16(Bt[n][k], At[m][k], acc[ai][bj][m][n], 0, 0, 0); __builtin_amdgcn_s_setprio(0); } while (0)
#define PG8_WAIT_V(n) asm volatile("s_waitcnt vmcnt(" #n ")" ::: "memory")
#define PG8_WAIT_L(n) asm volatile("s_waitcnt lgkmcnt(" #n ")" ::: "memory")
#define PG8_BAR __builtin_amdgcn_s_barrier()
#define PG8_SCHED __builtin_amdgcn_sched_barrier(0)
    Unit cur, nxt; int ui = 0;
    if (!S.next(0, cur)) return;
    f32x4 acc[2][2][4][2];
#pragma unroll
    for (int a = 0; a < 2; ++a)
#pragma unroll
        for (int b = 0; b < 2; ++b)
#pragma unroll
            for (int m = 0; m < 4; ++m)
#pragma unroll
                for (int n = 0; n < 2; ++n) acc[a][b][m][n] = (f32x4){0.f, 0.f, 0.f, 0.f};
    bf16x8 At[4][2], B0[2][2], B1[2][2];
    const char* cA = PG8_APTR(cur.pm); const char* cB = (const char*)g.Bt + (size_t)cur.pn * tstep;
    S.a_ready(cur);
    if constexpr (SP2) {
        PG8_STAGE(PG8_SB(0, 0), cB, voffB); PG8_STAGE(PG8_SB(0, 1), cB + hstep, voffB); PG8_STAGE(PG8_SA(0, 0), cA, voffA); PG8_STAGE(PG8_SA(0, 1), cA + hstepA, voffA);
        if (wr == 1) PG8_BAR;
        PG8_WAIT_V(2); PG8_BAR;
        PG8_STAGE(PG8_SB(1, 0), cB + kstep, voffB); PG8_STAGE(PG8_SA(1, 0), cA + kstep, voffA); PG8_STAGE(PG8_SB(1, 1), cB + hstep + kstep, voffB);
        PG8_WAIT_V(6); PG8_BAR;
    } else {
        PG8_STAGE(PG8_SB(0, 0), cB, voffB); PG8_STAGE(PG8_SA(0, 0), cA, voffA); PG8_STAGE(PG8_SB(0, 1), cB + hstep, voffB); PG8_STAGE(PG8_SA(0, 1), cA + hstepA, voffA);
        if (wr == 1) PG8_BAR;
        PG8_WAIT_V(4); PG8_BAR;
        PG8_STAGE(PG8_SB(1, 0), cB + kstep, voffB); PG8_STAGE(PG8_SA(1, 0), cA + kstep, voffA); PG8_STAGE(PG8_SB(1, 1), cB + hstep + kstep, voffB);
        PG8_WAIT_V(6); PG8_BAR;
    }
    for (;;) {
        const bool has_next = S.next(ui + 1, nxt);
        const char* nA = has_next ? PG8_APTR(nxt.pm) : cA; const char* nB = has_next ? (const char*)g.Bt + (size_t)nxt.pn * tstep : cB;
        for (int t = 0; t < nt; t += 2) {
            const bool last = (t == nt - 2);
            const char* a1 = cA + PG8_KOFFA(t + 1);
            const char* a2 = last ? nA : cA + PG8_KOFFA(t + 2); const char* b2 = last ? nB : cB + (size_t)(t + 2) * kstep;
            const char* a3 = a2 + kstep; const char* b3 = b2 + kstep;
            if (last && has_next) S.a_ready(nxt);
            if constexpr (SP2) {
            PG8_LDB(B0, 0, 0); PG8_LDB(B1, 0, 1); PG8_SCHED; PG8_LDA(At, 0, 0); PG8_STAGE(PG8_SA(1, 1), a1 + hstepA, voffA);
            PG8_WAIT_V(8); PG8_WAIT_L(0); PG8_BAR; PG8_MMA(0, 0, At, B0); PG8_MMA(0, 1, At, B1); PG8_BAR; PG8_SCHED;
            PG8_LDA(At, 0, 1); PG8_STAGE(PG8_SB(0, 0), b2, voffB); PG8_STAGE(PG8_SB(0, 1), b2 + hstep, voffB); PG8_STAGE(PG8_SA(0, 0), a2, voffA);
            PG8_WAIT_V(8); PG8_WAIT_L(0); PG8_BAR; PG8_MMA(1, 0, At, B0); PG8_MMA(1, 1, At, B1); PG8_BAR; PG8_SCHED;
            PG8_LDB(B0, 1, 0); PG8_LDB(B1, 1, 1); PG8_SCHED; PG8_LDA(At, 1, 0); PG8_STAGE(PG8_SA(0, 1), a2 + hstepA, voffA);
            PG8_WAIT_V(8); PG8_WAIT_L(0); PG8_BAR; PG8_MMA(0, 0, At, B0); PG8_MMA(0, 1, At, B1); PG8_BAR; PG8_SCHED;
            PG8_LDA(At, 1, 1); PG8_STAGE(PG8_SB(1, 0), b3, voffB); PG8_STAGE(PG8_SB(1, 1), b3 + hstep, voffB); PG8_STAGE(PG8_SA(1, 0), a3, voffA);
            PG8_WAIT_V(8); PG8_WAIT_L(0); PG8_BAR; PG8_MMA(1, 0, At, B0); PG8_MMA(1, 1, At, B1); PG8_BAR; PG8_SCHED;
            } else {
            PG8_LDB(B0, 0, 0); PG8_SCHED; PG8_LDA(At, 0, 0); PG8_STAGE(PG8_SA(1, 1), a1 + hstepA, voffA);
            PG8_WAIT_L(8); PG8_BAR; PG8_WAIT_L(0); PG8_MMA(0, 0, At, B0); PG8_BAR; PG8_SCHED;
            PG8_LDB(B1, 0, 1); PG8_STAGE(PG8_SB(0, 0), b2, voffB);
            PG8_BAR; PG8_WAIT_L(0); PG8_MMA(0, 1, At, B1); PG8_BAR;
            PG8_LDA(At, 0, 1); PG8_STAGE(PG8_SA(0, 0), a2, voffA);
            PG8_BAR; PG8_WAIT_L(0); PG8_MMA(1, 0, At, B0); PG8_BAR; PG8_SCHED;
            PG8_STAGE(PG8_SB(0, 1), b2 + hstep, voffB);
            PG8_WAIT_V(6); PG8_BAR; PG8_MMA(1, 1, At, B1); PG8_BAR;
            PG8_LDB(B0, 1, 0); PG8_SCHED; PG8_LDA(At, 1, 0); PG8_STAGE(PG8_SA(0, 1), a2 + hstepA, voffA);
            PG8_WAIT_L(8); PG8_BAR; PG8_WAIT_L(0); PG8_MMA(0, 0, At, B0); PG8_BAR; PG8_SCHED;
            PG8_LDB(B1, 1, 1); PG8_STAGE(PG8_SB(1, 0), b3, voffB);
            PG8_BAR; PG8_WAIT_L(0); PG8_MMA(0, 1, At, B1); PG8_BAR;
            PG8_LDA(At, 1, 1); PG8_STAGE(PG8_SA(1, 0), a3, voffA);
            PG8_BAR; PG8_WAIT_L(0); PG8_MMA(1, 0, At, B0); PG8_BAR; PG8_SCHED;
            PG8_STAGE(PG8_SB(1, 1), b3 + hstep, voffB);
            PG8_WAIT_V(6); PG8_BAR; PG8_MMA(1, 1, At, B1); PG8_BAR;
            }
        }
        if constexpr (ALIGN_EPI) { if (wr == 0) PG8_BAR; }
        if constexpr (!Epi::AFTER_DRAIN) { E(acc, cur, wr, wc, fr, fq); S.done(cur); }
        if (!has_next) break;
#pragma unroll
        for (int a = 0; a < 2; ++a)
#pragma unroll
            for (int b = 0; b < 2; ++b)
#pragma unroll
                for (int m = 0; m < 4; ++m)
#pragma unroll
                    for (int n = 0; n < 2; ++n) acc[a][b][m][n] = (f32x4){0.f, 0.f, 0.f, 0.f};
        cur = nxt; cA = nA; cB = nB; ++ui;
        if constexpr (ALIGN_EPI) { if (wr == 1) PG8_BAR; }
    }
    PG8_WAIT_V(0);
    if constexpr (!ALIGN_EPI) { if (wr == 0) PG8_BAR; }
    PG8_BAR;
    if constexpr (Epi::AFTER_DRAIN) { E.fused(acc, cur, wr, wc, fr, fq, lds, wid, lane); S.done(cur); }
#undef PG8_SA
#undef PG8_KOFFA
#undef PG8_APTR
#undef PG8_SB
#undef PG8_STAGE
#undef PG8_LDA
#undef PG8_LDB
#undef PG8_MMA
#undef PG8_WAIT_V
#undef PG8_WAIT_L
#undef PG8_BAR
#undef PG8_SCHED
}
}
#include <hip/hip_bf16.h>
#include <cmath>
namespace attn_body {
using bf16=__hip_bfloat16;
using bf16x8=__attribute__((ext_vector_type(8)))short;
using s16x4=__attribute__((ext_vector_type(4)))short;
using f32x16=__attribute__((ext_vector_type(16)))float;
using u32x4=__attribute__((ext_vector_type(4)))unsigned;
constexpr int BATCH=8,NHEAD=16,SEQ=4096,D=64,DM=NHEAD*D;
constexpr int NW=8,QBLK=32,QB=QBLK*NW,KVBLK=64,NQB=SEQ/QB;
constexpr int ATTN_PITCH=DM, ATTN_UNIT_ROWS=QB;
__device__ __forceinline__ int crow(int r,int hi){return (r&3)+8*(r>>2)+4*hi;}
#define SBAR() __builtin_amdgcn_sched_barrier(0)
__device__ __forceinline__ void cmask(f32x16&p0,f32x16&p1,int jb,int qrel,int hi){
  const float NEG=-INFINITY; int kb=64*jb+4*hi;
  #pragma unroll
  for(int r=0;r<16;++r){int kv=kb+(r&3)+8*(r>>2); if(kv>qrel)p0[r]=NEG; if(kv+32>qrel)p1[r]=NEG;}
}

constexpr int NSLOT=3, SLOTB=8192;
constexpr int LDS_K=0, LDS_V=NSLOT*SLOTB, LDS_WS=2*NSLOT*SLOTB, LDS_OST=LDS_WS+NW*64*4, LDS_BYTES=LDS_OST+NW*4096;
constexpr float C2=0.125f*1.4426950408889634f;
__device__ __forceinline__ void glds16(const void*gsrc,unsigned lds_dst){unsigned keep;
  asm volatile("s_mov_b32 %0, m0\n\ts_mov_b32 m0, %2\n\ts_nop 0\n\tglobal_load_lds_dwordx4 %1, off\n\ts_mov_b32 m0, %0":"=&s"(keep):"v"(gsrc),"s"(lds_dst):"memory");}
__device__ __forceinline__ float max3f(float a,float b,float c){float r;asm("v_max3_f32 %0, %1, %2, %3":"=v"(r):"v"(a),"v"(b),"v"(c));return r;}
__device__ __forceinline__ float max2f(float a,float b){float r;asm("v_max_f32_e32 %0, %1, %2":"=v"(r):"v"(a),"v"(b));return r;}
__device__ __forceinline__ float fadd_s(float a,float b){float r;asm("v_add_f32_e32 %0, %1, %2":"=v"(r):"v"(a),"v"(b));return r;}
__device__ __forceinline__ float fsub_s(float a,float b){float r;asm("v_sub_f32_e32 %0, %1, %2":"=v"(r):"v"(a),"v"(b));return r;}
typedef float f32x2_t __attribute__((ext_vector_type(2))); typedef __bf16 bf16x2_t __attribute__((ext_vector_type(2)));
__device__ __forceinline__ unsigned cvtpk_s(float lo,float hi){f32x2_t v={lo,hi};bf16x2_t b=__builtin_convertvector(v,bf16x2_t);return __builtin_bit_cast(unsigned,b);}
#define WAIT_BAR(N) asm volatile("s_waitcnt vmcnt(" #N ") lgkmcnt(0)\n\ts_barrier":::"memory")

__device__ __forceinline__ void qkt(f32x16&p0,f32x16&p1,const char*Kslot,const bf16x8*qr,const f32x16&negm,int r32,int hi){
  const char*kb=Kslot+hi*1024+r32*16;
  #pragma unroll
  for(int d0=0;d0<4;++d0){
    const bf16x8 b0=*reinterpret_cast<const bf16x8*>(kb+d0*2048);
    const bf16x8 b1=*reinterpret_cast<const bf16x8*>(kb+d0*2048+512);
    if(d0==0){p0=__builtin_amdgcn_mfma_f32_32x32x16_bf16(b0,qr[0],negm,0,0,0);p1=__builtin_amdgcn_mfma_f32_32x32x16_bf16(b1,qr[0],negm,0,0,0);}
    else{p0=__builtin_amdgcn_mfma_f32_32x32x16_bf16(b0,qr[d0],p0,0,0,0);p1=__builtin_amdgcn_mfma_f32_32x32x16_bf16(b1,qr[d0],p1,0,0,0);}}
}
typedef __attribute__((address_space(3))) const char* lds_cptr;
typedef short v4i16_t __attribute__((ext_vector_type(4)));
__device__ __forceinline__ void kload8(bf16x8*kf,lds_cptr kp){
  kf[0]=*(const __attribute__((address_space(3))) bf16x8*)(kp);      kf[1]=*(const __attribute__((address_space(3))) bf16x8*)(kp+512);
  kf[2]=*(const __attribute__((address_space(3))) bf16x8*)(kp+2048); kf[3]=*(const __attribute__((address_space(3))) bf16x8*)(kp+2560);
  kf[4]=*(const __attribute__((address_space(3))) bf16x8*)(kp+4096); kf[5]=*(const __attribute__((address_space(3))) bf16x8*)(kp+4608);
  kf[6]=*(const __attribute__((address_space(3))) bf16x8*)(kp+6144); kf[7]=*(const __attribute__((address_space(3))) bf16x8*)(kp+6656);
}
__device__ __forceinline__ void kload2(bf16x8*kf,lds_cptr kp,int j){ kf[2*j]=*(const __attribute__((address_space(3))) bf16x8*)(kp+j*2048); kf[2*j+1]=*(const __attribute__((address_space(3))) bf16x8*)(kp+j*2048+512); }
__device__ __forceinline__ s16x4 vtr(lds_cptr p){ return __builtin_bit_cast(s16x4,__builtin_amdgcn_ds_read_tr16_b64_v4i16((__attribute__((address_space(3))) v4i16_t*)p)); }
__device__ __forceinline__ float rowmax(const f32x16&p0,const f32x16&p1){
  float a=max3f(p0[0],p0[1],p1[0]),b=max3f(p0[2],p0[3],p1[1]);a=max3f(a,p1[2],p1[3]);
  #pragma unroll
  for(int r=4;r<16;r+=4){a=max3f(a,p0[r],p0[r+1]);b=max3f(b,p0[r+2],p0[r+3]);a=max3f(a,p1[r],p1[r+1]);b=max3f(b,p1[r+2],p1[r+3]);}
  const float m=max2f(a,b);
  auto rr=__builtin_amdgcn_permlane32_swap(__float_as_uint(m),__float_as_uint(m),false,false);
  return max2f(__uint_as_float(rr[0]),__uint_as_float(rr[1]));
}
__device__ __forceinline__ void pv(f32x16*o,int vb,bf16x8 pa0,bf16x8 pa1,bf16x8 pa2,bf16x8 pa3){
  #pragma unroll
  for(int d0=0;d0<2;++d0){s16x4 lo[4],hi[4];
    #pragma unroll
    for(int ks=0;ks<4;++ks){
      asm volatile("ds_read_b64_tr_b16 %0,%1 offset:%c2":"=&v"(lo[ks]):"v"(vb),"i"(d0*4096+ks*1024):"memory");
      asm volatile("ds_read_b64_tr_b16 %0,%1 offset:%c2":"=&v"(hi[ks]):"v"(vb),"i"(d0*4096+ks*1024+512):"memory");}
    asm volatile("s_waitcnt lgkmcnt(0)":::"memory");SBAR();
    #define PK(k) (bf16x8){lo[k][0],lo[k][1],lo[k][2],lo[k][3],hi[k][0],hi[k][1],hi[k][2],hi[k][3]}
    o[d0]=__builtin_amdgcn_mfma_f32_32x32x16_bf16(pa0,PK(0),o[d0],0,0,0);
    o[d0]=__builtin_amdgcn_mfma_f32_32x32x16_bf16(pa1,PK(1),o[d0],0,0,0);
    o[d0]=__builtin_amdgcn_mfma_f32_32x32x16_bf16(pa2,PK(2),o[d0],0,0,0);
    o[d0]=__builtin_amdgcn_mfma_f32_32x32x16_bf16(pa3,PK(3),o[d0],0,0,0);
    #undef PK
  }
}

#ifndef ATTN_STORE16
#define ATTN_STORE16(p,v) (*(u32x4*)(p)=(v))
#endif
template<int THRL> __device__ __forceinline__ void attn_unit(int b,int cq,int cv,int qb,const bf16*Q,const bf16*__restrict__ K,const bf16*__restrict__ V,bf16*O,char*shm){
  int tid_o_=threadIdx.x; asm volatile("":"+v"(tid_o_)); const int tid=tid_o_,lane=tid&63,r32=lane&31,hi=lane>>5; const int wid=__builtin_amdgcn_readfirstlane(tid>>6);
  const long rowbase=(long)b*SEQ; const int q0=qb*QB;
  const bf16*Qw=Q+(rowbase+q0+wid*QBLK)*DM+cq;
  const bf16*Kh=K+rowbase*DM+cq,*Vh=V+rowbase*DM+cv;
  const unsigned lds0=(unsigned)(uintptr_t)shm;
  float*wsf=(float*)(shm+LDS_WS)+wid*64;
  const bf16*ksrc=Kh+(long)lane*DM+wid*8;
  const bf16*vsrc=Vh+(long)(16*(wid&3)+(lane>>2))*DM+(wid>>2)*32+(lane&3)*8;
  const unsigned kdst=lds0+LDS_K+wid*1024, vdst=lds0+LDS_V+wid*1024;
  #define DMA_K(t,slot) glds16(ksrc+(long)(t)*KVBLK*DM,(unsigned)__builtin_amdgcn_readfirstlane(kdst+(slot)))
  #define DMA_V(t,slot) glds16(vsrc+(long)(t)*KVBLK*DM,(unsigned)__builtin_amdgcn_readfirstlane(vdst+(slot)))
  const int vb0=(int)(lds0+LDS_V)+((lane>>4)&1)*32+(lane&3)*8+(4*hi+((lane&15)>>2))*64;
  const char*Kbase=shm+LDS_K; bf16x8 kf[8];
  const lds_cptr shm3=(lds_cptr)shm; const lds_cptr kp0=shm3+LDS_K+hi*1024+r32*16; const lds_cptr vp0=shm3+LDS_V+((lane>>4)&1)*32+(lane&3)*8+(4*hi+((lane&15)>>2))*64;
  const int NT=(q0+QB)/KVBLK;
  DMA_K(0,0);DMA_V(0,0);DMA_K(1,SLOTB);
  bf16x8 qr[4];
  #pragma unroll
  for(int d0=0;d0<4;++d0)qr[d0]=*reinterpret_cast<const bf16x8*>(&Qw[(long)r32*DM+d0*16+hi*8]);
  float mhat=0.f,l_reg=0.f;f32x16 o[2];o[0]=f32x16{};o[1]=f32x16{};f32x16 negm=f32x16{};asm volatile("":"+v"(negm));
  const int qrel=wid*QBLK+r32;
  #define CMASK(P0,P1,t) do{int jb_=(t)-(NT-4); if(jb_>=0)cmask(P0,P1,jb_,qrel,hi);}while(0)
  bool resc=false;
  #define START(P0,P1) do{ const float rm=rowmax(P0,P1); resc=false; \
    { const float dl=rm; mhat=fadd_s(mhat,dl); \
      _Pragma("unroll") for(int r=0;r<16;++r){P0[r]=fsub_s(P0[r],dl);P1[r]=fsub_s(P1[r],dl);} \
      _Pragma("unroll") for(int r=0;r<16;++r)negm[r]=-mhat; asm volatile("":"+v"(negm)); } \
    _Pragma("unroll") for(int r=0;r<16;++r)P0[r]=__builtin_amdgcn_exp2f(P0[r]); }while(0)
  #define RESC() do{ if(resc){ asm volatile("s_waitcnt lgkmcnt(0)":::"memory"); \
      _Pragma("unroll") for(int d_=0;d_<2;++d_) _Pragma("unroll") for(int r=0;r<16;++r)o[d_][r]*=wsf[crow(r,hi)]; } }while(0)
  f32x16 pA0,pA1,pB0,pB1;
  int sl_prev=0,sl_cur=0,sl_next=SLOTB;
  #define ROT() do{sl_prev=sl_cur;sl_cur=sl_next;sl_next=(sl_next==(NSLOT-1)*SLOTB)?0:sl_next+SLOTB;}while(0)
  DMA_K(2,2*SLOTB);
  WAIT_BAR(3);
  qkt(pA0,pA1,Kbase,qr,negm,r32,hi);asm volatile("s_nop 15\n\ts_nop 7":"+v"(pA0),"+v"(pA1));CMASK(pA0,pA1,0);
  START(pA0,pA1);
  _Pragma("unroll") for(int r=0;r<16;++r)pA1[r]=__builtin_amdgcn_exp2f(pA1[r]);
  WAIT_BAR(0);
  DMA_K(3,0);DMA_V(1,SLOTB);
  ROT();
  kload8(kf,kp0+sl_cur);
  WAIT_BAR(2);
  s16x4 vlo[8],vhi[8]; u32x4 pw0,pw1,pw2,pw3;
  #define PKW(P,B) cvtpk_s(P[B],P[B+1])
  #define PAF(k) __builtin_bit_cast(bf16x8,pw##k)
  #define VFR(i) (bf16x8){vlo[i][0],vlo[i][1],vlo[i][2],vlo[i][3],vhi[i][0],vhi[i][1],vhi[i][2],vhi[i][3]}
  #define PIN(x) asm volatile("":"+v"(x))
  #define MX3(a,b,c) __builtin_fmaxf(__builtin_fmaxf((a),(b)),(c))
  #define GAPA(MF,A0,A1,A2,A3,W0,W1,PW) do{ MF; sacc+=A0; sacc+=A1; sacc+=A2; sacc+=A3; PIN(sacc); W0; W1; PIN(PW); SBAR(); }while(0)
  #define EX(v) __builtin_amdgcn_exp2f(v)
  #define GAPB(MF,X,B) do{ MF; X[B]=EX(X[B]); X[B+1]=EX(X[B+1]); X[B+2]=EX(X[B+2]); X[B+3]=EX(X[B+3]); PIN(X); SBAR(); }while(0)
  #define VRD(i) do{ vlo[i]=vtr(vp_+(((i)>>2)*4096+((i)&3)*1024)); vhi[i]=vtr(vp_+(((i)>>2)*4096+((i)&3)*1024+512)); }while(0)
  #define KRD(G,j) do{ if(G){ kload2(kf,kp0+sl_next,j); SBAR(); } }while(0)
  #define STEP(C0,C1,P0,P1,t,GK,GV,GL) do{ SBAR(); \
    const lds_cptr vp_=vp0+sl_prev; \
    VRD(0); SBAR(); float sacc=(P0[0]+P0[1]); \
    GAPA(C0=__builtin_amdgcn_mfma_f32_32x32x16_bf16(kf[0],qr[0],negm,0,0,0), P0[2],P0[3],P0[4],P0[5],     pw0[0]=PKW(P0,0), pw0[1]=PKW(P0,2), pw0); \
    VRD(4); SBAR(); GAPA(C1=__builtin_amdgcn_mfma_f32_32x32x16_bf16(kf[1],qr[0],negm,0,0,0), P0[6],P0[7],P0[8],P0[9],     pw0[2]=PKW(P0,4), pw0[3]=PKW(P0,6), pw0); \
    VRD(1); SBAR(); GAPA(C0=__builtin_amdgcn_mfma_f32_32x32x16_bf16(kf[2],qr[1],C0,0,0,0),   P0[10],P0[11],P0[12],P0[13], pw1[0]=PKW(P0,8), pw1[1]=PKW(P0,10), pw1); \
    VRD(5); SBAR(); GAPA(C1=__builtin_amdgcn_mfma_f32_32x32x16_bf16(kf[3],qr[1],C1,0,0,0),   P0[14],P0[15],P1[0],P1[1],   pw1[2]=PKW(P0,12),pw1[3]=PKW(P0,14), pw1); \
    VRD(2); SBAR(); GAPA(C0=__builtin_amdgcn_mfma_f32_32x32x16_bf16(kf[4],qr[2],C0,0,0,0),   P1[2],P1[3],P1[4],P1[5],     pw2[0]=PKW(P1,0), pw2[1]=PKW(P1,2), pw2); \
    VRD(6); SBAR(); GAPA(C1=__builtin_amdgcn_mfma_f32_32x32x16_bf16(kf[5],qr[2],C1,0,0,0),   P1[6],P1[7],P1[8],P1[9],     pw2[2]=PKW(P1,4), pw2[3]=PKW(P1,6), pw2); \
    VRD(3); SBAR(); GAPA(C0=__builtin_amdgcn_mfma_f32_32x32x16_bf16(kf[6],qr[3],C0,0,0,0),   P1[10],P1[11],P1[12],P1[13], pw3[0]=PKW(P1,8), pw3[1]=PKW(P1,10), pw3); \
    VRD(7); SBAR(); GAPA(C1=__builtin_amdgcn_mfma_f32_32x32x16_bf16(kf[7],qr[3],C1,0,0,0),   P1[14],P1[15],0.f,0.f,       pw3[2]=PKW(P1,12),pw3[3]=PKW(P1,14), pw3); \
    l_reg+=sacc; \
    if(GK){DMA_K((t)+3,sl_cur);} if(GV){DMA_V((t)+1,sl_next);} \
    CMASK(C0,C1,t); \
    { float a=MX3(C0[0],C0[1],C1[0]),b=MX3(C0[2],C0[3],C1[1]); a=MX3(a,C1[2],C1[3]); \
      _Pragma("unroll") for(int r=4;r<16;r+=4){a=MX3(a,C0[r],C0[r+1]);b=MX3(b,C0[r+2],C0[r+3]);a=MX3(a,C1[r],C1[r+1]);b=MX3(b,C1[r+2],C1[r+3]);} \
      float rm=__builtin_fmaxf(a,b); { auto rr=__builtin_amdgcn_permlane32_swap(__float_as_uint(rm),__float_as_uint(rm),false,false); rm=__builtin_fmaxf(__uint_as_float(rr[0]),__uint_as_float(rr[1])); } \
      resc=false; \
      if(__builtin_expect(__any(rm>(float)THRL),0)){ const float dl=__builtin_fmaxf(rm,0.f); mhat+=dl; \
        _Pragma("unroll") for(int r=0;r<16;++r){C0[r]-=dl;C1[r]-=dl;} \
        _Pragma("unroll") for(int r=0;r<16;++r)negm[r]=-mhat; asm volatile("":"+v"(negm)); \
        const float f=__builtin_amdgcn_exp2f(-dl); l_reg*=f; if(hi==0)wsf[r32]=f; resc=true; } } \
    SBAR(); \
    GAPB(o[0]=__builtin_amdgcn_mfma_f32_32x32x16_bf16(PAF(0),VFR(0),o[0],0,0,0), C0,0); \
    GAPB(o[1]=__builtin_amdgcn_mfma_f32_32x32x16_bf16(PAF(0),VFR(4),o[1],0,0,0), C0,4); \
    KRD(GL,0); GAPB(o[0]=__builtin_amdgcn_mfma_f32_32x32x16_bf16(PAF(1),VFR(1),o[0],0,0,0), C0,8); \
    KRD(GL,1); GAPB(o[1]=__builtin_amdgcn_mfma_f32_32x32x16_bf16(PAF(1),VFR(5),o[1],0,0,0), C0,12); \
    KRD(GL,2); GAPB(o[0]=__builtin_amdgcn_mfma_f32_32x32x16_bf16(PAF(2),VFR(2),o[0],0,0,0), C1,0); \
    KRD(GL,3); GAPB(o[1]=__builtin_amdgcn_mfma_f32_32x32x16_bf16(PAF(2),VFR(6),o[1],0,0,0), C1,4); \
    GAPB(o[0]=__builtin_amdgcn_mfma_f32_32x32x16_bf16(PAF(3),VFR(3),o[0],0,0,0), C1,8); \
    GAPB(o[1]=__builtin_amdgcn_mfma_f32_32x32x16_bf16(PAF(3),VFR(7),o[1],0,0,0), C1,12); \
    }while(0)
  int t=1;
  #undef CMASK
  #define CMASK(P0,P1,t) do{}while(0)
  for(;t+5<NT;t+=2){
    STEP(pB0,pB1,pA0,pA1,t,true,true,true);     WAIT_BAR(2); RESC(); ROT();
    STEP(pA0,pA1,pB0,pB1,t+1,true,true,true);   WAIT_BAR(2); RESC(); ROT();
  }
  #undef CMASK
  #define CMASK(P0,P1,t) do{int jb_=(t)-(NT-4); if(jb_>=0)cmask(P0,P1,jb_,qrel,hi);}while(0)
  #define ENDW(tt) do{ if((tt)+3<NT){WAIT_BAR(2);} else if((tt)+2<NT){WAIT_BAR(1);} else {WAIT_BAR(0);} }while(0)
  for(;t+1<NT;t+=2){
    STEP(pB0,pB1,pA0,pA1,t,(t+3<NT),(t+1<NT),(t+1<NT));       ENDW(t);   RESC(); ROT();
    STEP(pA0,pA1,pB0,pB1,t+1,(t+4<NT),(t+2<NT),(t+2<NT));     ENDW(t+1); RESC(); ROT();
  }
  STEP(pB0,pB1,pA0,pA1,NT-1,false,false,false); RESC();
  { float sacc=pB0[0]+pB0[1]; _Pragma("unroll") for(int r=2;r<16;++r)sacc+=pB0[r]; _Pragma("unroll") for(int r=0;r<16;++r)sacc+=pB1[r]; l_reg+=sacc;
    pw0=(u32x4){PKW(pB0,0),PKW(pB0,2),PKW(pB0,4),PKW(pB0,6)};pw1=(u32x4){PKW(pB0,8),PKW(pB0,10),PKW(pB0,12),PKW(pB0,14)};pw2=(u32x4){PKW(pB1,0),PKW(pB1,2),PKW(pB1,4),PKW(pB1,6)};pw3=(u32x4){PKW(pB1,8),PKW(pB1,10),PKW(pB1,12),PKW(pB1,14)};
    SBAR(); pv(o,vb0+sl_cur,PAF(0),PAF(1),PAF(2),PAF(3)); }
  #undef PKW
  #undef PAF
  #undef VFR
  #undef PIN
  #undef MX3
  #undef GAPA
  #undef GAPB
  #undef EX
  #undef VRD
  #undef KRD
  #undef STEP
  #undef ENDW
  {auto rr=__builtin_amdgcn_permlane32_swap(__float_as_uint(l_reg),__float_as_uint(l_reg),false,false);l_reg=__uint_as_float(rr[0])+__uint_as_float(rr[1]);}
  if(hi==0)wsf[32+r32]=l_reg;asm volatile("s_waitcnt lgkmcnt(0)":::"memory");
  float rli[16];
  #pragma unroll
  for(int r=0;r<16;++r)rli[r]=__builtin_amdgcn_rcpf(wsf[32+crow(r,hi)]);
  bf16*Ow=O+(rowbase+q0+wid*QBLK)*DM+cv;
  { bf16*stg=(bf16*)(shm+LDS_OST)+wid*2048;
    #pragma unroll
    for(int r=0;r<16;++r){const int orow=crow(r,hi);
      #pragma unroll
      for(int d0=0;d0<2;++d0)stg[orow*64+d0*32+r32]=__float2bfloat16(o[d0][r]*rli[r]);}
    asm volatile("s_waitcnt lgkmcnt(0)":::"memory");
    #pragma unroll
    for(int i=0;i<4;++i){const int row=i*8+(lane>>3),ch=lane&7; const u32x4 v=*(const u32x4*)(stg+row*64+ch*8); ATTN_STORE16(Ow+(long)row*DM+ch*8,v);} }
  asm volatile("s_waitcnt lgkmcnt(0)\n\ts_barrier":::"memory");
  #undef DMA_K
  #undef DMA_V
  #undef CMASK
  #undef START
  #undef RESC
  #undef ROT
}
constexpr int ATTN_LDS_BYTES=LDS_BYTES;
#undef SBAR
#undef WAIT_BAR
}
#define LAS __attribute__((address_space(3)))
using pg8::bf16_t; using pg8::f32x4; using pg8::u32x4; using pg8::bf16x8; using pg8::cvt_pk_bf16; using pg8::f32x2;
typedef unsigned u32x2 __attribute__((ext_vector_type(2)));
constexpr int NB = 8, S = 4096, D = 1024, T = NB * S, FF = 2816, FF2 = 5632, SP = S + 8;
constexpr int NWAVES = 8, NTHR = 512;
constexpr size_t MiB = 1u << 20;
constexpr size_t WS_W = 0, WS_H = 112 * MiB, WS_A = 177 * MiB;
constexpr size_t WS_VF = WS_A, WS_L = WS_A + 64 * MiB, WS_R = WS_A + 96 * MiB, WS_K = WS_A + 160 * MiB, WS_V1 = WS_A + 224 * MiB;
constexpr size_t WS_ACT_R = WS_R;
constexpr size_t WS_KS = WS_A, WS_VS = WS_A + 64 * MiB, WS_Q = WS_A + 128 * MiB, WS_O0 = WS_A + 192 * MiB, WS_O1 = WS_A + 256 * MiB;
constexpr size_t WS_HK = WS_O0, WS_ACT_B = WS_Q;
constexpr size_t WS_MOD = 497 * MiB, WS_ROPE = 498 * MiB, WS_CTL = 499 * MiB, WS_END = 500 * MiB, WS_MODP = WS_R;
constexpr size_t WS_SS = WS_CTL + 131072;
constexpr size_t WS_BIASUP = WS_ROPE + 262144;
constexpr size_t WS_BIASQ = WS_MOD + 786432;
constexpr size_t WS_KVNC = WS_BIASQ + 65536;
static_assert((size_t)(NB * SP + 128) * D * 2 <= 65 * MiB, "H");
static_assert((size_t)T * FF * 2 <= 176 * MiB, "act");
constexpr size_t NRKVL = 3584;
constexpr size_t WE_RWKV = NRKVL * 2048 + (size_t)D * D + (size_t)D * 320;
constexpr size_t WE_FFN = (size_t)FF2 * D + (size_t)D * FF;
__host__ __device__ constexpr size_t we_rkvl(int l) { return (size_t)l * WE_RWKV; }
__host__ __device__ constexpr size_t we_woa(int l) { return we_rkvl(l) + NRKVL * 2048; }
__host__ __device__ constexpr size_t we_lb(int l) { return we_woa(l) + (size_t)D * D; }
__host__ __device__ constexpr size_t we_up(int l) { return 2 * WE_RWKV + (size_t)l * WE_FFN; }
__host__ __device__ constexpr size_t we_dn(int l) { return we_up(l) + (size_t)FF2 * D; }
constexpr size_t WE_KV = 2 * WE_RWKV + 4 * WE_FFN;
__host__ __device__ constexpr size_t we_q(int j) { return WE_KV + (size_t)2 * D * D + (size_t)j * D * D; }
__host__ __device__ constexpr size_t we_ob(int j) { return WE_KV + (size_t)4 * D * D + (size_t)j * D * D; }
static_assert((WE_KV + (size_t)6 * D * D) * 2 <= 112 * MiB, "weights");
constexpr int LDS_BYTES = 147456;

__device__ __forceinline__ float bf2f(unsigned short h) { return __uint_as_float((unsigned)h << 16); }

template <int CTRL> __device__ __forceinline__ float dppf(float v) { return __int_as_float(__builtin_amdgcn_update_dpp(0, __float_as_int(v), CTRL, 0xf, 0xf, true)); }
__device__ __forceinline__ float sigm(float x) { return __builtin_amdgcn_rcpf(1.f + __expf(-x)); }
__device__ __forceinline__ float row16_sum(float v) { v += dppf<0xB1>(v); v += dppf<0x4E>(v); v += dppf<0x141>(v); v += dppf<0x140>(v); return v; }
__device__ __forceinline__ float row8_sum(float v) { v += dppf<0xB1>(v); v += dppf<0x4E>(v); v += dppf<0x141>(v); return v; }
__device__ __forceinline__ float xlane16(float v) { return v + __int_as_float(__builtin_amdgcn_ds_swizzle(__float_as_int(v), 0x401F)); }
__device__ __forceinline__ float xlane32(float v) { auto rr = __builtin_amdgcn_permlane32_swap(__float_as_uint(v), __float_as_uint(v), false, false); return __uint_as_float(rr[0]) + __uint_as_float(rr[1]); }
__device__ __forceinline__ float wave_sum_dpp(float v) {
    v = row16_sum(v);
    return __int_as_float(__builtin_amdgcn_readlane(__float_as_int(v), 0)) + __int_as_float(__builtin_amdgcn_readlane(__float_as_int(v), 16)) +
           __int_as_float(__builtin_amdgcn_readlane(__float_as_int(v), 32)) + __int_as_float(__builtin_amdgcn_readlane(__float_as_int(v), 48));
}
__device__ __forceinline__ float wave_sum(float v) { return wave_sum_dpp(v); }
#define BAR_LDS() asm volatile("s_waitcnt lgkmcnt(0)\n\ts_barrier" ::: "memory")

#define GAS __attribute__((address_space(1)))
#define GLD4(p, boff) (*(const GAS f32x4*)((const GAS char*)(p) + (unsigned)(boff)))
struct EpiRkvL {
    static constexpr bool PERM = true, AFTER_DRAIN = false;
    bf16_t *R, *K, *V, *L;
    __device__ __forceinline__ void operator()(const f32x4 (&acc)[2][2][4][2], const pg8::Unit& u, int wr, int wc, int fr, int fq) const {
        { int t_ = threadIdx.x; asm volatile("" : "+v"(t_)); fr = t_ & 15; fq = (t_ >> 4) & 3; }
        const int pn = u.pn; const int ldc = pn < 12 ? D : 512, colt = pn < 12 ? (pn & 3) * 256 : (pn - 12) * 256;
        unsigned long long bp = (unsigned long long)(uintptr_t)L;
        if (pn < 12) bp = (unsigned long long)(uintptr_t)V;
        asm volatile("" : "+s"(bp));
        if (pn < 8) bp = (unsigned long long)(uintptr_t)K;
        asm volatile("" : "+s"(bp));
        if (pn < 4) bp = (unsigned long long)(uintptr_t)R;
        GAS char* base = (GAS char*)(uintptr_t)bp;
        const int row0 = u.pm * 256 + wr * 64 + fr, col0 = colt + wc * 32 + 8 * fq;
#pragma unroll
        for (int ai = 0; ai < 2; ++ai)
#pragma unroll
            for (int m = 0; m < 4; ++m) { const unsigned off = ((unsigned)(row0 + ai * 128 + m * 16) * (unsigned)ldc + (unsigned)col0) * 2u;
#pragma unroll
                for (int bj = 0; bj < 2; ++bj) { f32x4 v0 = acc[ai][bj][m][0], v1 = acc[ai][bj][m][1];
                    if (pn >= 12) {
                        const int c0 = col0 + bj * 128;
                        const int ty = c0 < 64 ? 1 : ((c0 >= 160 && c0 < 320) ? 2 : 0);
                        if (ty) { const float A = ty == 1 ? 2.f : 1.f, C = ty == 1 ? -1.f : 0.f;
#pragma unroll
                            for (int e = 0; e < 4; ++e) { v0[e] = A * sigm(A * v0[e]) + C; v1[e] = A * sigm(A * v1[e]) + C; } } }
                    u32x4 w; w.x = cvt_pk_bf16(v0[0], v0[1]); w.y = cvt_pk_bf16(v0[2], v0[3]); w.z = cvt_pk_bf16(v1[0], v1[1]); w.w = cvt_pk_bf16(v1[2], v1[3]);
                    *(GAS u32x4*)(base + off + bj * 256) = w; } }
    }
};
struct EpiRes {
    static constexpr bool PERM = false, AFTER_DRAIN = false;
    const float* base; float* out; unsigned char* wsb; const float* nwn; unsigned gate_off, sc_off, ss_off; int next;
    __device__ __forceinline__ void operator()(const f32x4 (&acc)[2][2][4][2], const pg8::Unit& u, int wr, int wc, int fr, int fq) const {
        { int t_ = threadIdx.x; asm volatile("" : "+v"(t_)); fr = t_ & 15; fq = (t_ >> 4) & 3; }
        const int b = u.pm >> 4, col0 = u.pn * 256 + wc * 32 + 4 * fq;
        f32x4 gv[2][2], gm[2][2];
#pragma unroll
        for (int bj = 0; bj < 2; ++bj)
#pragma unroll
            for (int n = 0; n < 2; ++n) { gv[bj][n] = GLD4(wsb, gate_off + (b * 6144 + col0 + bj * 128 + n * 16) * 4);
                gm[bj][n] = next ? GLD4(nwn, (col0 + bj * 128 + n * 16) * 4) * (GLD4(wsb, sc_off + (b * 6144 + col0 + bj * 128 + n * 16) * 4) + 1.f) : gv[bj][n]; }
#pragma unroll
        for (int ai = 0; ai < 2; ++ai) {
            f32x4 bsa[4][2][2];
#pragma unroll
            for (int m = 0; m < 4; ++m) { const unsigned off = ((unsigned)(u.pm * 256 + ai * 128 + wr * 64 + m * 16 + fr) * (unsigned)D + (unsigned)col0) * 4u;
#pragma unroll
                for (int bj = 0; bj < 2; ++bj)
#pragma unroll
                    for (int n = 0; n < 2; ++n) bsa[m][bj][n] = GLD4(base, off + bj * 512 + n * 64); }
#pragma unroll
            for (int m = 0; m < 4; ++m) { const int row = u.pm * 256 + ai * 128 + wr * 64 + m * 16 + fr; const unsigned off = ((unsigned)row * (unsigned)D + (unsigned)col0) * 4u;
                f32x4 bs[2][2];
#pragma unroll
                for (int bj = 0; bj < 2; ++bj)
#pragma unroll
                    for (int n = 0; n < 2; ++n) { bs[bj][n] = bsa[m][bj][n] + gv[bj][n] * acc[ai][bj][m][n]; *(GAS f32x4*)((GAS char*)out + (off + bj * 512 + n * 64)) = bs[bj][n]; }
                if (next) { float sq = 0.f; const unsigned hoff = (unsigned)WS_H + ((unsigned)(b * SP + 8 + (row & (S - 1))) * (unsigned)D + (unsigned)col0) * 2u;
#pragma unroll
                    for (int bj = 0; bj < 2; ++bj)
#pragma unroll
                        for (int n = 0; n < 2; ++n) { const f32x4 x = bs[bj][n]; sq += (x[0] * x[0] + x[1] * x[1]) + (x[2] * x[2] + x[3] * x[3]); const f32x4 h = x * gm[bj][n];
                            u32x2 w; w.x = cvt_pk_bf16(h[0], h[1]); w.y = cvt_pk_bf16(h[2], h[3]); *(GAS u32x2*)((GAS char*)wsb + (hoff + bj * 256 + n * 32)) = w;
                            if (next == 2) { const f32x4 k = x * GLD4(wsb, (unsigned)WS_KVNC + (col0 + bj * 128 + n * 16) * 4); u32x2 w2; w2.x = cvt_pk_bf16(k[0], k[1]); w2.y = cvt_pk_bf16(k[2], k[3]);
                                *(GAS u32x2*)((GAS char*)wsb + ((unsigned)(WS_HK - WS_H) + hoff + bj * 256 + n * 32)) = w2; } }
                    sq = xlane32(xlane16(sq));
                    if (fq == 0) (void)__builtin_amdgcn_global_atomic_fadd_f32((GAS float*)((GAS char*)wsb + ss_off) + row, sq); }
            }
        }
    }
};
struct EpiRope {
    static constexpr bool PERM = false, AFTER_DRAIN = false;
    unsigned char* wsb; unsigned oa_off, ob_off, ss_off, bias_off; float scale0; int defer, hasbias;
    __device__ __forceinline__ void operator()(const f32x4 (&acc)[2][2][4][2], const pg8::Unit& u, int wr, int wc, int fr, int fq) const {
        { int t_ = threadIdx.x; asm volatile("" : "+v"(t_)); fr = t_ & 15; fq = (t_ >> 4) & 3; }
        const bool ra = u.pn < 4; GAS char* O = (GAS char*)wsb + (ra ? oa_off : ob_off); const float sc = ra ? scale0 : 1.f;
        const int col0 = (u.pn & 3) * 256 + wc * 32 + 4 * fq; const bool dorope = ra && ((wc & 1) == 0) && fq < 2;
#pragma unroll
        for (int ai = 0; ai < 2; ++ai)
#pragma unroll
            for (int m = 0; m < 4; ++m) { const int row = u.pm * 256 + ai * 128 + wr * 64 + m * 16 + fr; const int t = row & (S - 1);
                const float rs = defer ? rsqrtf(*(const GAS float*)((const GAS char*)wsb + (ss_off + (unsigned)row * 4u)) * (1.f / D) + 1e-6f) : 1.f;
                f32x4 cs = {1.f, 1.f, 1.f, 1.f}, sn = {0.f, 0.f, 0.f, 0.f};
                if (dorope) { cs = GLD4(wsb, (unsigned)WS_ROPE + (t * 8 + 4 * fq) * 4); sn = GLD4(wsb, (unsigned)WS_ROPE + (S * 8 + t * 8 + 4 * fq) * 4); }
#pragma unroll
                for (int bj = 0; bj < 2; ++bj) { f32x4 x1 = acc[ai][bj][m][0] * rs, x2 = acc[ai][bj][m][1] * rs;
                    if (hasbias) { const unsigned bo = bias_off + (unsigned)((u.pm >> 4) * D + col0 + bj * 128) * 4u; x1 = x1 + GLD4(wsb, bo); x2 = x2 + GLD4(wsb, bo + 64); }
                    const f32x4 o1 = (x1 * cs - x2 * sn) * sc, o2 = (x2 * cs + x1 * sn) * sc;
                    u32x2 w1, w2; w1.x = cvt_pk_bf16(o1[0], o1[1]); w1.y = cvt_pk_bf16(o1[2], o1[3]); w2.x = cvt_pk_bf16(o2[0], o2[1]); w2.y = cvt_pk_bf16(o2[2], o2[3]);
                    const unsigned off = ((unsigned)row * (unsigned)D + (unsigned)(col0 + bj * 128)) * 2u; *(GAS u32x2*)(O + off) = w1; *(GAS u32x2*)(O + off + 32) = w2; } }
    }
};
struct EpiUp {
    static constexpr bool PERM = false, AFTER_DRAIN = false;
    unsigned char* wsb; const float* cw; const float* cb; unsigned act_off, ss_off, bias_off;
    __device__ __forceinline__ void operator()(const f32x4 (&acc)[2][2][4][2], const pg8::Unit& u, int wr, int wc, int fr, int fq) const {
        { int t_ = threadIdx.x; asm volatile("" : "+v"(t_)); fr = t_ & 15; fq = (t_ >> 4) & 3; }
        const int b = u.pm / 17, ui = u.pm % 17;
#pragma unroll
        for (int n = 0; n < 2; ++n) { const int ch0 = 128 * u.pn + 32 * wc + 16 * n + 4 * fq;
            const unsigned bo_ = bias_off + (unsigned)(b * FF2 + 256 * u.pn + 32 * wc + 16 * n + 4 * fq) * 4u;
#pragma unroll
            for (int ai = 0; ai < 2; ++ai) { const int tb = 248 * ui + 62 * (2 * ai + wr) - 2;
                float rs[4];
#pragma unroll
                for (int m = 0; m < 4; ++m) { const int t = tb + 16 * m + fr; const bool in = t >= 0 && t < S;
                    rs[m] = in ? rsqrtf(*(const GAS float*)((const GAS char*)wsb + (ss_off + (unsigned)(b * S + (in ? t : 0)) * 4u)) * (1.f / D) + 1e-6f) : 0.f; }
                const bool z0 = (tb + fr) < 0;
                f32x4 ug[4];
                { const f32x4 w0 = GLD4(cw, ch0 * 4), w1 = GLD4(cw, (FF2 + ch0) * 4), w2 = GLD4(cw, (2 * FF2 + ch0) * 4), bb = GLD4(cb, ch0 * 4), bu0 = GLD4(wsb, bo_);
                    f32x4 q1 = bb, q2 = bb;
#pragma unroll
                    for (int m = 0; m < 4; ++m) { f32x4 x = acc[ai][0][m][n] * rs[m] + bu0; if (m == 0 && z0) x = (f32x4){0.f, 0.f, 0.f, 0.f}; f32x4 r1, r2;
#pragma unroll
                        for (int j = 0; j < 4; ++j) { r1[j] = dppf<0x121>(x[j]); r2[j] = dppf<0x122>(x[j]); }
                        const f32x4 p1 = fr == 0 ? q1 : r1, p2 = fr < 2 ? q2 : r2; ug[m] = bb + w0 * p2 + w1 * p1 + w2 * x; q1 = r1; q2 = r2; } }
                { const int c = ch0 + FF; const f32x4 w0 = GLD4(cw, c * 4), w1 = GLD4(cw, (FF2 + c) * 4), w2 = GLD4(cw, (2 * FF2 + c) * 4), bb = GLD4(cb, c * 4), bu1 = GLD4(wsb, bo_ + 512);
                    f32x4 q1 = bb, q2 = bb;
#pragma unroll
                    for (int m = 0; m < 4; ++m) { f32x4 x = acc[ai][1][m][n] * rs[m] + bu1; if (m == 0 && z0) x = (f32x4){0.f, 0.f, 0.f, 0.f}; f32x4 r1, r2;
#pragma unroll
                        for (int j = 0; j < 4; ++j) { r1[j] = dppf<0x121>(x[j]); r2[j] = dppf<0x122>(x[j]); }
                        const f32x4 p1 = fr == 0 ? q1 : r1, p2 = fr < 2 ? q2 : r2; const f32x4 uv = bb + w0 * p2 + w1 * p1 + w2 * x; q1 = r1; q2 = r2;
                        const int rr = 16 * m + fr, t = tb + rr; const f32x4 g = ug[m]; f32x4 o;
#pragma unroll
                        for (int j = 0; j < 4; ++j) o[j] = g[j] * sigm(g[j]) * uv[j];
                        if (rr >= 2 && t < S) { u32x2 w; w.x = cvt_pk_bf16(o[0], o[1]); w.y = cvt_pk_bf16(o[2], o[3]); *(GAS u32x2*)((GAS char*)wsb + (act_off + ((unsigned)(b * S + t) * (unsigned)FF + (unsigned)ch0) * 2u)) = w; } } }
                __builtin_amdgcn_sched_barrier(0);
            } }
    }
};

struct Job { const float* W; const float* mu; bf16_t* Bt; int ldw, K, N, ldb, kdst0, mode, map, rowoff, start; };
__device__ __forceinline__ int colmap(int map, int n) {
    if (map == 1) { const int half = n >= FF ? 1 : 0, ch = n - half * FF; return 256 * (ch >> 7) + 128 * half + (ch & 127); }
    if (map == 2) { const int d = n & 63; const int p = (d >= 8 && d < 16) ? d + 8 : ((d >= 16 && d < 24) ? d - 8 : d); return (n & ~63) + p; }
    return n;
}
__device__ __forceinline__ void tr_load(const LAS Job* jb, int item, float (&v)[32], int lane) {
    const float* W = jb->W; const float* mu = jb->mu; const int ldw = jb->ldw, N = jb->N, mode = jb->mode;
    const int nblk = N / 32, kb = item / nblk, nb = item % nblk, k0 = 64 * kb, n0 = 32 * nb;
#pragma unroll
    for (int i = 0; i < 32; ++i) { const int kk = 2 * i + (lane >> 5); float x = W[(size_t)(k0 + kk) * ldw + n0 + (lane & 31)];
        if (mode) { const float m = mu[k0 + kk]; x *= (mode == 1) ? (1.f - m) : m; }
        v[i] = x; }
}
__device__ __forceinline__ void tr_store(const LAS Job* jb, int item, const float (&v)[32], LAS float* scr, int lane) {
    bf16_t* Bt = jb->Bt; const int N = jb->N, ldb = jb->ldb, kdst0 = jb->kdst0, map = jb->map, rowoff = jb->rowoff;
    const int nblk = N / 32, kb = item / nblk, nb = item % nblk, k0 = 64 * kb, n0 = 32 * nb;
#pragma unroll
    for (int i = 0; i < 32; ++i) scr[(2 * i + (lane >> 5)) * 33 + (lane & 31)] = v[i];
    asm volatile("s_waitcnt lgkmcnt(0)" ::: "memory");
    const int c = lane & 7;
#pragma unroll
    for (int j = 0; j < 4; ++j) { const int n = (lane >> 3) + 8 * j; const LAS float* s = scr + (8 * c) * 33 + n;
        u32x4 o; o.x = cvt_pk_bf16(s[0 * 33], s[1 * 33]); o.y = cvt_pk_bf16(s[2 * 33], s[3 * 33]); o.z = cvt_pk_bf16(s[4 * 33], s[5 * 33]); o.w = cvt_pk_bf16(s[6 * 33], s[7 * 33]);
        *(u32x4*)(Bt + (size_t)(rowoff + colmap(map, n0 + n)) * ldb + kdst0 + k0 + 8 * c) = o; }
    asm volatile("s_waitcnt lgkmcnt(0)" ::: "memory");
}
__device__ __forceinline__ float rope_inv(int i) {
    return i == 0 ? 1.0f : i == 1 ? 0.1939227432012558f : i == 2 ? 0.03760603070259094f : i == 3 ? 0.007292664609849453f : i == 4 ? 0.0014142135623842478f
         : i == 5 ? 0.00027424818836152554f : i == 6 ? 5.3182957344688475e-05f : 1.0313385246263351e-05f;
}

__device__ __forceinline__ void norm_phase(const float* x, const float* nw, const float* modl, int shoff, int scoff, bf16_t* H, const float* kvn, bf16_t* HK, int gw, int NGW, int lane) {
    for (int row = gw; row < T; row += NGW) {
        const int b = row >> 12, t = row & (S - 1);
        const f32x4* xr = (const f32x4*)(x + (size_t)row * D) + lane;
        f32x4 v[4]; float ss = 0.f;
#pragma unroll
        for (int j = 0; j < 4; ++j) { v[j] = xr[64 * j]; ss += (v[j].x * v[j].x + v[j].y * v[j].y) + (v[j].z * v[j].z + v[j].w * v[j].w); }
        const float rstd = rsqrtf(wave_sum(ss) * (1.f / D) + 1e-6f);
        const float* mb = modl + (size_t)b * 6144;
        const size_t orow = ((size_t)b * SP + 8 + t) * D;
#pragma unroll
        for (int j = 0; j < 4; ++j) { const int col = 4 * (lane + 64 * j);
            const f32x4 g = *(const f32x4*)(nw + col), sc = *(const f32x4*)(mb + scoff + col), sh = *(const f32x4*)(mb + shoff + col);
            const f32x4 y = v[j] * rstd * g; const f32x4 h = y * (sc + 1.f) + sh;
            u32x2 w; w.x = cvt_pk_bf16(h[0], h[1]); w.y = cvt_pk_bf16(h[2], h[3]); *(u32x2*)(H + orow + col) = w;
            if (HK) { const f32x4 k = v[j] * rstd * *(const f32x4*)(kvn + col); u32x2 w2; w2.x = cvt_pk_bf16(k[0], k[1]); w2.y = cvt_pk_bf16(k[2], k[3]); *(u32x2*)(HK + orow + col) = w2; } }
    }
}
__device__ __forceinline__ void final_norm_phase(float* x, const float* nw, int gw, int NGW, int lane) {
    for (int row = gw; row < T; row += NGW) {
        f32x4* xr = (f32x4*)(x + (size_t)row * D) + lane;
        f32x4 v[4]; float ss = 0.f;
#pragma unroll
        for (int j = 0; j < 4; ++j) { v[j] = xr[64 * j]; ss += (v[j].x * v[j].x + v[j].y * v[j].y) + (v[j].z * v[j].z + v[j].w * v[j].w); }
        const float rstd = rsqrtf(wave_sum(ss) * (1.f / D) + 1e-6f);
#pragma unroll
        for (int j = 0; j < 4; ++j) xr[64 * j] = v[j] * rstd * *(const f32x4*)(nw + 4 * (lane + 64 * j));
    }
}
__device__ __forceinline__ void combine_phase(bf16_t* O0, const bf16_t* O1, const float* lamv, const float* subln, float lam_init, int gw, int NGW, int lane) {
    const float d01 = wave_sum(lamv[lane] * lamv[64 + lane]), d23 = wave_sum(lamv[128 + lane] * lamv[192 + lane]);
    const float lam = __expf(d01) - __expf(d23) + lam_init, osc = 1.f - lam_init;
    float sw[16];
#pragma unroll
    for (int i = 0; i < 16; ++i) sw[i] = subln[(16 * lane + i) & 127] * osc;
    for (int row = gw; row < T; row += NGW) {
        bf16_t* p0 = O0 + (size_t)row * D + 16 * lane; const bf16_t* p1 = O1 + (size_t)row * D + 16 * lane;
        const u32x4 a0 = *(const u32x4*)p0, a1 = *(const u32x4*)(p0 + 8), b0 = *(const u32x4*)p1, b1 = *(const u32x4*)(p1 + 8);
        float o[16]; float ss = 0.f;
#pragma unroll
        for (int i = 0; i < 4; ++i) { const unsigned ua = a0[i], ub = b0[i], uc = a1[i], ud = b1[i];
            o[2 * i] = __uint_as_float(ua << 16) - lam * __uint_as_float(ub << 16); o[2 * i + 1] = __uint_as_float(ua & 0xffff0000u) - lam * __uint_as_float(ub & 0xffff0000u);
            o[8 + 2 * i] = __uint_as_float(uc << 16) - lam * __uint_as_float(ud << 16); o[8 + 2 * i + 1] = __uint_as_float(uc & 0xffff0000u) - lam * __uint_as_float(ud & 0xffff0000u); }
#pragma unroll
        for (int i = 0; i < 16; ++i) ss += o[i] * o[i];
        ss = row8_sum(ss);
        const float rstd = rsqrtf(ss * (1.f / 128.f) + 1e-6f);
        u32x4 w0, w1;
#pragma unroll
        for (int i = 0; i < 4; ++i) { w0[i] = cvt_pk_bf16(o[2 * i] * rstd * sw[2 * i], o[2 * i + 1] * rstd * sw[2 * i + 1]); w1[i] = cvt_pk_bf16(o[8 + 2 * i] * rstd * sw[8 + 2 * i], o[9 + 2 * i] * rstd * sw[9 + 2 * i]); }
        *(u32x4*)p0 = w0; *(u32x4*)(p0 + 8) = w1;
    }
}
struct ScanP { const bf16_t *R, *K, *V, *VF, *L; bf16_t* Y; const bf16_t* LB; const float *w0, *a0, *v0, *kk, *ka, *rk, *lnw, *lnb; int vres; };
__device__ __forceinline__ unsigned f2bf1(float f) { const unsigned u = __float_as_uint(f); return (u + 0x7fffu + ((u >> 16) & 1u)) >> 16; }
typedef __bf16 bf16x2c_t __attribute__((ext_vector_type(2)));
__device__ __forceinline__ unsigned cvtpk_c(float lo, float hi) { f32x2 v = {lo, hi}; bf16x2c_t b = __builtin_convertvector(v, bf16x2c_t); return __builtin_bit_cast(unsigned, b); }
template <int ACT> __device__ __forceinline__ bf16x8 act_frag(bf16x8 a) {
    float f[8];
#pragma unroll
    for (int e = 0; e < 8; ++e) { const float x = bf2f((unsigned short)a[e]); f[e] = ACT == 1 ? (2.f * sigm(2.f * x) - 1.f) : sigm(x); }
    u32x4 w; w.x = cvtpk_c(f[0], f[1]); w.y = cvtpk_c(f[2], f[3]); w.z = cvtpk_c(f[4], f[5]); w.w = cvtpk_c(f[6], f[7]);
    return __builtin_bit_cast(bf16x8, w);
}
__device__ __forceinline__ float hsum4(f32x4 v) { return (v.x + v.y) + (v.z + v.w); }
__device__ __forceinline__ void scan_phase(LAS unsigned char* lds, const ScanP& P, int G) {
    int tid_o_ = threadIdx.x; asm volatile("" : "+v"(tid_o_)); const int tid = tid_o_, lane = tid & 63, wave = __builtin_amdgcn_readfirstlane(tid >> 6);
    LAS float* ring = (LAS float*)lds;
    LAS float* ybuf = (LAS float*)(lds + 86016);
    constexpr int RB = 16 * 7 * 64;
    for (int item0 = blockIdx.x; item0 < NB * 16; item0 += G) {
        const int item = (G % 8 == 0) ? ((item0 & 7) * 16 + (item0 >> 3)) : item0;
        const int b = item >> 4, hd = item & 15; const size_t row0 = (size_t)b * S;
        if (wave < 4) {
            const int q = wave, p = lane & 7, rp = lane >> 3;
            f32x4 s0a = {0.f, 0.f, 0.f, 0.f}, s0b = s0a, s1a = s0a, s1b = s0a;
            BAR_LDS();
            int cb = 0;
            for (int c = 0; c < S / 16; ++c) {
                const LAS float* rb = ring + cb * RB; LAS float* yb = ybuf + (c & 1) * 1024;
#define CLOAD(W_, A_, B_, K_, R_, V_, tt) do { const LAS float* bs_ = rb + (tt) * 448 + 8 * p; \
                    W_[0] = *(const LAS f32x4*)(bs_); W_[1] = *(const LAS f32x4*)(bs_ + 4); A_[0] = *(const LAS f32x4*)(bs_ + 64); A_[1] = *(const LAS f32x4*)(bs_ + 68); \
                    B_[0] = *(const LAS f32x4*)(bs_ + 128); B_[1] = *(const LAS f32x4*)(bs_ + 132); K_[0] = *(const LAS f32x4*)(bs_ + 192); K_[1] = *(const LAS f32x4*)(bs_ + 196); \
                    R_[0] = *(const LAS f32x4*)(bs_ + 256); R_[1] = *(const LAS f32x4*)(bs_ + 260); V_ = *(const LAS f32x2*)(rb + (tt) * 448 + 320 + 16 * q + 2 * rp); } while (0)
                f32x4 cw[2], ca[2], cbv[2], ck[2], cr[2]; f32x2 cv;
                CLOAD(cw, ca, cbv, ck, cr, cv, 0);
#pragma unroll
                for (int t = 0; t < 16; ++t) {
                    f32x4 nw[2], na[2], nbv[2], nk[2], nr[2]; f32x2 nv;
                    if (t < 15) CLOAD(nw, na, nbv, nk, nr, nv, t + 1);
                    float sa0 = hsum4(s0a * ca[0] + s0b * ca[1]), sa1 = hsum4(s1a * ca[0] + s1b * ca[1]);
                    sa0 = row8_sum(sa0); sa1 = row8_sum(sa1);
                    s0a = s0a * cw[0] + (cbv[0] * sa0 + ck[0] * cv.x); s0b = s0b * cw[1] + (cbv[1] * sa0 + ck[1] * cv.x);
                    s1a = s1a * cw[0] + (cbv[0] * sa1 + ck[0] * cv.y); s1b = s1b * cw[1] + (cbv[1] * sa1 + ck[1] * cv.y);
                    float y0 = hsum4(s0a * cr[0] + s0b * cr[1]), y1 = hsum4(s1a * cr[0] + s1b * cr[1]);
                    y0 = row8_sum(y0); y1 = row8_sum(y1);
                    if (p < 2) yb[t * 64 + 16 * q + 2 * rp + p] = p ? y1 : y0;
                    if (t < 15) {
#pragma unroll
                        for (int e = 0; e < 2; ++e) { cw[e] = nw[e]; ca[e] = na[e]; cbv[e] = nbv[e]; ck[e] = nk[e]; cr[e] = nr[e]; }
                        cv = nv; }
                }
#undef CLOAD
                BAR_LDS();
                cb = cb == 2 ? 0 : cb + 1;
            }
        } else {
            const int j = wave - 4, fr = lane & 15, fq = lane >> 4;
            const int gch = hd * 64 + 16 * j + fr;
            const float w0c = P.w0[gch], a0c = P.a0[gch], v0c = P.vres ? P.v0[gch] : 0.f, kkc = P.kk[gch], kac = P.ka[gch];
            const f32x4 kk4 = *(const f32x4*)(P.kk + hd * 64 + 4 * fr);
            const f32x4 lnw4 = *(const f32x4*)(P.lnw + hd * 64 + 4 * fr), lnb4 = *(const f32x4*)(P.lnb + hd * 64 + 4 * fr), rk4 = *(const f32x4*)(P.rk + hd * 64 + 4 * fr);
            bf16x8 bfr[10];
#pragma unroll
            for (int i = 0; i < 10; ++i) bfr[i] = *(const bf16x8*)(P.LB + (size_t)gch * 320 + 32 * i + 8 * fq);
            bf16x8 afr[10]; unsigned short rr[4], kr[4], vr[4], vfr[4]; u32x2 k4[4];
#define SC_LOAD(cc) do { const size_t r0_ = row0 + 16 * (size_t)(cc); const bf16_t* lp_ = P.L + (r0_ + fr) * 512 + 8 * fq; \
                _Pragma("unroll") for (int i = 0; i < 10; ++i) afr[i] = *(const bf16x8*)(lp_ + 32 * i); \
                _Pragma("unroll") for (int i = 0; i < 4; ++i) { const size_t rw_ = (r0_ + 4 * fq + i) * D; rr[i] = P.R[rw_ + gch]; kr[i] = P.K[rw_ + gch]; vr[i] = P.V[rw_ + gch]; \
                    vfr[i] = P.vres ? P.VF[rw_ + gch] : (unsigned short)0; k4[i] = *(const u32x2*)(P.K + rw_ + hd * 64 + 4 * fr); } } while (0)
#define SC_PROC(nb) do { const f32x4 z_ = {0.f, 0.f, 0.f, 0.f}; \
                f32x4 wl = __builtin_amdgcn_mfma_f32_16x16x32_bf16(afr[0], bfr[0], z_, 0, 0, 0); wl = __builtin_amdgcn_mfma_f32_16x16x32_bf16(afr[1], bfr[1], wl, 0, 0, 0); \
                f32x4 al = __builtin_amdgcn_mfma_f32_16x16x32_bf16(afr[2], bfr[2], z_, 0, 0, 0); al = __builtin_amdgcn_mfma_f32_16x16x32_bf16(afr[3], bfr[3], al, 0, 0, 0); \
                f32x4 vl = __builtin_amdgcn_mfma_f32_16x16x32_bf16(afr[4], bfr[4], z_, 0, 0, 0); \
                f32x4 gl = __builtin_amdgcn_mfma_f32_16x16x32_bf16(afr[5], bfr[5], z_, 0, 0, 0); \
                _Pragma("unroll") for (int i = 6; i < 10; ++i) gl = __builtin_amdgcn_mfma_f32_16x16x32_bf16(afr[i], bfr[i], gl, 0, 0, 0); \
                _Pragma("unroll") for (int i = 0; i < 4; ++i) { \
                    const float e0 = __uint_as_float(k4[i].x << 16) * kk4.x, e1 = __uint_as_float(k4[i].x & 0xffff0000u) * kk4.y, e2 = __uint_as_float(k4[i].y << 16) * kk4.z, e3 = __uint_as_float(k4[i].y & 0xffff0000u) * kk4.w; \
                    const float ss = row16_sum((e0 * e0 + e1 * e1) + (e2 * e2 + e3 * e3)); const float rn = 1.f / fmaxf(sqrtf(ss), 1e-12f); \
                    const float r = bf2f(rr[i]), k = bf2f(kr[i]); float v = bf2f(vr[i]); \
                    const float dec = __expf(-0.6065306597126334f * sigm(w0c + wl[i])); const float a = sigm(a0c + al[i]); \
                    if (P.vres) { const float vg = sigm(v0c + vl[i]); v = v + (bf2f(vfr[i]) - v) * vg; } \
                    const float kkn = k * kkc * rn, kp = k * (1.f + (a - 1.f) * kac); \
                    LAS float* o_ = ring + ((nb) * 16 + 4 * fq + i) * 448 + 16 * j + fr; \
                    o_[0] = dec; o_[64] = -kkn; o_[128] = kkn * a; o_[192] = kp; o_[256] = r; o_[320] = v; o_[384] = gl[i]; } } while (0)
#define SC_POST(pc, pb) do { const int tk = 4 * j + fq; const LAS float* bs = ring + ((pb) * 16 + tk) * 448 + 4 * fr; \
                const f32x4 y = *(const LAS f32x4*)(ybuf + ((pc) & 1) * 1024 + tk * 64 + 4 * fr), kp = *(const LAS f32x4*)(bs + 192), r = *(const LAS f32x4*)(bs + 256), v = *(const LAS f32x4*)(bs + 320), g = *(const LAS f32x4*)(bs + 384); \
                const float s1 = row16_sum(hsum4(y)), s2 = row16_sum(hsum4(y * y)), s3 = row16_sum(hsum4(r * kp * rk4)); \
                const float mean = s1 * (1.f / 64.f), var = fmaxf(s2 * (1.f / 64.f) - mean * mean, 0.f), rstd = rsqrtf(var + 64e-5f); \
                const f32x4 o = ((y - mean) * rstd * lnw4 + lnb4 + v * s3) * g; \
                u32x2 w_; w_.x = cvt_pk_bf16(o[0], o[1]); w_.y = cvt_pk_bf16(o[2], o[3]); \
                *(u32x2*)(P.Y + (row0 + 16 * (size_t)(pc) + tk) * D + hd * 64 + 4 * fr) = w_; } while (0)
            SC_LOAD(0); SC_PROC(0); SC_LOAD(1);
            BAR_LDS();
            int cb = 0;
            for (int c = 0; c < S / 16; ++c) {
                const int nb = cb == 2 ? 0 : cb + 1, pb = cb == 0 ? 2 : cb - 1;
                if (c + 1 < S / 16) SC_PROC(nb);
                if (c + 2 < S / 16) SC_LOAD(c + 2);
                if (c >= 1) SC_POST(c - 1, pb);
                BAR_LDS();
                cb = nb;
            }
            { const int pb = cb == 0 ? 2 : cb - 1; SC_POST(S / 16 - 1, pb); }
#undef SC_LOAD
#undef SC_PROC
#undef SC_POST
        }
        BAR_LDS();
    }
}

#define XB_TMO      128
#define XB_XCNT(j)  (256  + 64 * (j))
#define XB_XSUB(j)  (1280 + 64 * (j))
#define XB_XGEN(j)  (2304 + 64 * (j))
#define XB_TOP      3328
#define XB_TOPGEN   3392
#define XCD_BAR_WORDS 3456
#define XB_SPIN_CAP (1u << 18)

__device__ __forceinline__ unsigned xb_ld(unsigned* p)              { return __hip_atomic_load(p, __ATOMIC_RELAXED, __HIP_MEMORY_SCOPE_AGENT); }
__device__ __forceinline__ unsigned xb_add(unsigned* p, unsigned v) { return __hip_atomic_fetch_add(p, v, __ATOMIC_RELAXED, __HIP_MEMORY_SCOPE_AGENT); }
__device__ __forceinline__ unsigned xb_xcc_id() { return (unsigned)__builtin_amdgcn_s_getreg((3 << 11) | 20) & 0xFu; }
#define XB_SPIN(cond, bar) do { unsigned _sp = 0; while (cond) { __builtin_amdgcn_s_sleep(1); \
    if ((++_sp & 255u) == 0u) { if (xb_ld(&(bar)[XB_TMO])) break; if (_sp > XB_SPIN_CAP) { atomicAdd(&(bar)[XB_TMO], 1u); break; } } } } while (0)

struct XcdBarrier {
    unsigned* bar; unsigned x;
    volatile LAS unsigned* st;
};

__device__ __forceinline__ XcdBarrier xcd_barrier_post(unsigned* bar, volatile LAS unsigned* st) {
    XcdBarrier b; b.bar = bar; b.x = xb_xcc_id(); b.st = st;
    if (threadIdx.x == 0) (void)xb_add(&bar[XB_XCNT(b.x)], 1u);
    return b;
}
__device__ __forceinline__ void xcd_barrier_complete(unsigned* bar, unsigned x, unsigned& nloc, unsigned& nx) {
    const unsigned G = gridDim.x * gridDim.y * gridDim.z;
    unsigned sum, cnt, mine, sp = 0u;
    for (;;) {
        sum = 0u; cnt = 0u; mine = 0u;
#pragma unroll
        for (unsigned j = 0; j < 16; ++j) { const unsigned c = xb_ld(&bar[XB_XCNT(j)]); sum += c; cnt += (c > 0u) ? 1u : 0u; mine = (j == x) ? c : mine; }
        if (sum == G) break;
        __builtin_amdgcn_s_sleep(1);
        if ((++sp & 255u) == 0u) { if (xb_ld(&bar[XB_TMO])) break; if (sp > XB_SPIN_CAP) { atomicAdd(&bar[XB_TMO], 1u); break; } }
    }
    nloc = mine > 0u ? mine : 1u; nx = cnt > 0u ? cnt : 1u;
}

__device__ __forceinline__ void xcd_barrier(const XcdBarrier& b) {
    asm volatile("s_waitcnt vmcnt(0)" ::: "memory");
    __syncthreads();
    if (threadIdx.x == 0) {
        unsigned* bar = b.bar;
        __builtin_amdgcn_s_waitcnt(0);
        unsigned nloc = b.st[0], nx = b.st[1];
        if (nloc == 0u) { xcd_barrier_complete(bar, b.x, nloc, nx); b.st[0] = nloc; b.st[1] = nx; }
        const unsigned old = xb_add(&bar[XB_XSUB(b.x)], 1u);
        const unsigned gen = old / nloc;
        if (old + 1u == (gen + 1u) * nloc) {
            __builtin_amdgcn_fence(__ATOMIC_RELEASE, "agent");
            asm volatile("s_waitcnt vmcnt(0)" ::: "memory");
            const unsigned og = xb_add(&bar[XB_TOP], 1u);
            const unsigned tg = og / nx;
            if (og + 1u == (tg + 1u) * nx) xb_add(&bar[XB_TOPGEN], 1u);
            else XB_SPIN(xb_ld(&bar[XB_TOPGEN]) == tg, bar);
            __builtin_amdgcn_fence(__ATOMIC_ACQUIRE, "agent");
            xb_add(&bar[XB_XGEN(b.x)], 1u);
            asm volatile("s_waitcnt vmcnt(0)" ::: "memory");
        } else {
            XB_SPIN(xb_ld(&bar[XB_XGEN(b.x)]) == gen, bar);
            __builtin_amdgcn_fence(__ATOMIC_ACQUIRE, "agent");
            asm volatile("s_waitcnt vmcnt(0)" ::: "memory");
        }
    }
    __syncthreads();
}

struct Args { const float* in[36]; float* out; unsigned char* ws; };
#ifndef DBG
#define DBG 0
#endif
__device__ __forceinline__ void dbg_dump(float* out, const bf16_t* A, const bf16_t* B, const bf16_t* C, const bf16_t* L, int g0, int gn) {
    for (size_t i = g0; i < (size_t)T * D; i += gn) { float s = 0.f; if (A) s += bf2f(A[i]); if (B) s += bf2f(B[i]); if (C) s += bf2f(C[i]); if (L) s += bf2f(L[(i >> 10) * 512 + (i & 511)]); out[i] = s; }
}
enum { I_X = 0, I_C, I_ADAW, I_ADAB, I_N1, I_N2, I_FN, I_MU, I_WRKV, I_W0, I_W1, I_W2, I_A0, I_A1, I_A2, I_V0, I_V1, I_V2, I_G1, I_G2, I_KK, I_KA, I_RK, I_LNW, I_LNB, I_WOA,
       I_KVN, I_WKV, I_WQ, I_LAM, I_SUBLN, I_WOB, I_UP, I_CW, I_CB, I_DN };

__global__ void __launch_bounds__(NTHR, 2) yoco_fwd(Args a) {
    extern __shared__ __attribute__((aligned(16))) unsigned char lds_raw[];
    LAS unsigned char* lds = (LAS unsigned char*)lds_raw;
    cg::grid_group grid = cg::this_grid();
#define OPQ(x) ({ int o_ = (x); asm volatile("" : "+s"(o_)); o_; })
#define TIDX() ({ int t_ = threadIdx.x; asm volatile("" : "+v"(t_)); t_; })
#define tid TIDX()
#define lane (TIDX() & 63)
#define gtid (bx * NTHR + TIDX())
    const int wave = __builtin_amdgcn_readfirstlane((int)threadIdx.x >> 6);
    const int G = gridDim.x, bx = blockIdx.x, gw = bx * NWAVES + wave, NGW = G * NWAVES, NTOT = G * NTHR;
    unsigned char* ws = a.ws;
    LAS unsigned long long* ptab = (LAS unsigned long long*)(lds + 131072);
    if (tid == 0) {
#pragma unroll
        for (int i = 0; i < 36; ++i) ptab[i] = (unsigned long long)(uintptr_t)a.in[i]; }
    if (TIDX() < 64) ((LAS unsigned*)(lds + 131072 + 512))[TIDX()] = 0u;
    __syncthreads();
    grid.sync();
    (void)xcd_barrier_post((unsigned*)(ws + WS_CTL), (volatile LAS unsigned*)(lds + 131072 + 512) + 8);
#define PTABW(i) ({ unsigned o_ = 131072u + 8u * (unsigned)(i); asm volatile("" : "+v"(o_)); *(LAS unsigned long long*)o_; })
#define INP(i) ({ const unsigned long long w_ = PTABW(i); (const float*)(uintptr_t)(((unsigned long long)(unsigned)__builtin_amdgcn_readfirstlane((int)(w_ >> 32)) << 32) | (unsigned long long)(unsigned)__builtin_amdgcn_readfirstlane((int)(unsigned)w_)); })
    bf16_t* Wb = (bf16_t*)(ws + WS_W); bf16_t* H = (bf16_t*)(ws + WS_H);
    float* MOD = (float*)(ws + WS_MOD); float* ROPE = (float*)(ws + WS_ROPE); float* MODP = (float*)(ws + WS_MODP);
    float* out = a.out;
#define SYNC() do { XcdBarrier b_; b_.bar = (unsigned*)(ws + WS_CTL); b_.x = xb_xcc_id(); b_.st = (volatile LAS unsigned*)(lds + 131072 + 512) + 8; xcd_barrier(b_); } while (0)

    {
        LAS float* cact = (LAS float*)(lds + 69632);
        for (int i = tid; i < NB * D; i += NTHR) { const float c = INP(I_C)[i]; cact[(i & (D - 1)) * 8 + (i >> 10)] = c / (1.f + expf(-c)); }
        __syncthreads();
        for (int i = gtid; i < NB * 8 * 128; i += NTOT) { const int b = i >> 10, r = (i >> 7) & 7, c8 = i & 127; *(u32x4*)(H + ((size_t)b * SP + r) * D + 8 * c8) = (u32x4){0u, 0u, 0u, 0u}; }
        for (int i = gtid; i < S * 8; i += NTOT) { const float ang = (float)(i >> 3) * rope_inv(i & 7); ROPE[i] = cosf(ang); ROPE[S * 8 + i] = sinf(ang); }
        for (int it = gw; it < 4 * 24 * 32; it += NGW) {
            const int ks = it & 31, cc = (it >> 5) % 24, l = it / (32 * 24);
            f32x4 acc[8];
#pragma unroll
            for (int b = 0; b < 8; ++b) acc[b] = (f32x4){0.f, 0.f, 0.f, 0.f};
            const float* wp = INP(I_ADAW) + ((size_t)l * D + 32 * ks) * 6144 + 256 * cc + 4 * lane;
#pragma unroll 8
            for (int kk = 0; kk < 32; ++kk) { const f32x4 w = *(const f32x4*)(wp + (size_t)kk * 6144); const LAS float* cp = cact + (32 * ks + kk) * 8;
                const f32x4 c0 = *(const LAS f32x4*)cp, c1 = *(const LAS f32x4*)(cp + 4);
                acc[0] += w * c0.x; acc[1] += w * c0.y; acc[2] += w * c0.z; acc[3] += w * c0.w; acc[4] += w * c1.x; acc[5] += w * c1.y; acc[6] += w * c1.z; acc[7] += w * c1.w; }
#pragma unroll
            for (int b = 0; b < 8; ++b) *(f32x4*)(MODP + ((size_t)(ks * 4 + l) * 8 + b) * 6144 + 256 * cc + 4 * lane) = acc[b];
        }
        LAS Job* jobs = (LAS Job*)(lds + 102400); int nj = 0, tot = 0;
#define ADDJOB(W_, mu_, Bt_, ldw_, K_, N_, ldb_, kdst0_, mode_, map_, rowoff_) do { if (tid == 0) { LAS Job* jb = jobs + nj; jb->W = (W_); jb->mu = (mu_); jb->Bt = (Bt_); jb->ldw = (ldw_); jb->K = (K_); jb->N = (N_); \
            jb->ldb = (ldb_); jb->kdst0 = (kdst0_); jb->mode = (mode_); jb->map = (map_); jb->rowoff = (rowoff_); jb->start = tot; } tot += ((K_) / 64) * ((N_) / 32); ++nj; asm volatile("" ::: "memory"); } while (0)
        for (int l = 0; l < 2; ++l) {
            const float* mu = INP(I_MU) + (size_t)l * 6 * D; bf16_t* B = Wb + we_rkvl(l);
            for (int i = 0; i < 3; ++i) { const float* W = INP(I_WRKV) + (size_t)(l * 3 + i) * D * D; const float* m = mu + (i == 0 ? 0 : (i == 1 ? 2 : 3)) * D;
                ADDJOB(W, m, B, D, D, D, 2048, 0, 1, 0, i * D); ADDJOB(W, m, B, D, D, D, 2048, D, 2, 0, i * D); }
            ADDJOB(INP(I_W1) + (size_t)l * D * 64, mu + 1 * D, B, 64, D, 64, 2048, 0, 1, 0, 3072); ADDJOB(INP(I_W1) + (size_t)l * D * 64, mu + 1 * D, B, 64, D, 64, 2048, D, 2, 0, 3072);
            ADDJOB(INP(I_A1) + (size_t)l * D * 64, mu + 4 * D, B, 64, D, 64, 2048, 0, 1, 0, 3136); ADDJOB(INP(I_A1) + (size_t)l * D * 64, mu + 4 * D, B, 64, D, 64, 2048, D, 2, 0, 3136);
            if (l == 1) { ADDJOB(INP(I_V1), mu + 3 * D, B, 32, D, 32, 2048, 0, 1, 0, 3200); ADDJOB(INP(I_V1), mu + 3 * D, B, 32, D, 32, 2048, D, 2, 0, 3200); }
            ADDJOB(INP(I_G1) + (size_t)l * D * 160, mu + 5 * D, B, 160, D, 160, 2048, 0, 1, 0, 3232); ADDJOB(INP(I_G1) + (size_t)l * D * 160, mu + 5 * D, B, 160, D, 160, 2048, D, 2, 0, 3232);
            ADDJOB(INP(I_WOA) + (size_t)l * D * D, nullptr, Wb + we_woa(l), D, D, D, D, 0, 0, 0, 0);
        }
        for (int l = 0; l < 4; ++l) {
            ADDJOB(INP(I_UP) + (size_t)l * D * FF2, nullptr, Wb + we_up(l), FF2, D, FF2, D, 0, 0, 1, 0);
            ADDJOB(INP(I_DN) + (size_t)l * FF * D, nullptr, Wb + we_dn(l), D, FF, D, FF, 0, 0, 0, 0);
        }
        ADDJOB(INP(I_WKV), nullptr, Wb + WE_KV, 2048, D, D, D, 0, 0, 2, 0); ADDJOB(INP(I_WKV) + D, nullptr, Wb + WE_KV, 2048, D, D, D, 0, 0, 0, D);
        for (int j = 0; j < 2; ++j) { ADDJOB(INP(I_WQ) + (size_t)j * D * D, nullptr, Wb + we_q(j), D, D, D, D, 0, 0, 2, 0); ADDJOB(INP(I_WOB) + (size_t)j * D * D, nullptr, Wb + we_ob(j), D, D, D, D, 0, 0, 0, 0); }
#undef ADDJOB
        __syncthreads();
        LAS float* scr = (LAS float*)(lds + wave * 8704); int jn = 0;
        {
            float va[32], vb[32]; int it = gw, jc = 0, ic = 0;
            if (it < tot) { while (jn + 1 < nj && jobs[jn + 1].start <= it) ++jn; jc = jn; ic = it - jobs[jn].start; tr_load(jobs + jc, ic, va, lane); }
            while (it < tot) {
                int it2 = it + NGW, j2 = jc, i2 = 0;
                if (it2 < tot) { while (jn + 1 < nj && jobs[jn + 1].start <= it2) ++jn; j2 = jn; i2 = it2 - jobs[jn].start; tr_load(jobs + j2, i2, vb, lane); }
                tr_store(jobs + jc, ic, va, scr, lane);
                it = it2 + NGW; jc = j2; ic = i2;
                if (it2 >= tot) break;
                int j3 = jc, i3 = 0;
                if (it < tot) { while (jn + 1 < nj && jobs[jn + 1].start <= it) ++jn; j3 = jn; i3 = it - jobs[jn].start; tr_load(jobs + j3, i3, va, lane); }
                tr_store(jobs + jc, ic, vb, scr, lane);
                jc = j3; ic = i3;
            }
        }
        for (int i = gtid; i < 2 * 40 * D; i += NTOT) { const int l = i / (40 * D), r = i % (40 * D), kg = r >> 10, n = r & (D - 1), k = 8 * kg;
            const float* src = nullptr;
            if (k < 64) src = INP(I_W2) + ((size_t)l * 64 + k) * D; else if (k < 128) src = INP(I_A2) + ((size_t)l * 64 + (k - 64)) * D;
            else if (k < 160) src = (l == 1) ? INP(I_V2) + (size_t)(k - 128) * D : nullptr; else src = INP(I_G2) + ((size_t)l * 160 + (k - 160)) * D;
            float f[8];
#pragma unroll
            for (int e = 0; e < 8; ++e) f[e] = src ? src[(size_t)e * D + n] : 0.f;
            u32x4 w; w.x = cvt_pk_bf16(f[0], f[1]); w.y = cvt_pk_bf16(f[2], f[3]); w.z = cvt_pk_bf16(f[4], f[5]); w.w = cvt_pk_bf16(f[6], f[7]);
            *(u32x4*)(Wb + we_lb(l) + (size_t)n * 320 + k) = w; }
    }
    SYNC();
    {
        for (int i = gtid; i < 4 * 8 * 6144; i += NTOT) { const int n = i % 6144, l = i / (8 * 6144); float s = INP(I_ADAB)[l * 6144 + n];
#pragma unroll 8
            for (int ks = 0; ks < 32; ++ks) s += MODP[(size_t)ks * (4 * 8 * 6144) + i];
            MOD[i] = s; }
    }
    SYNC();

#define BIAS_WORK(W0_, NW_) do { \
                for (int i = (W0_) * 64 + lane; i < D; i += (NW_) * 64) ((float*)(ws + WS_KVNC))[i] = INP(I_KVN)[i]; \
                for (int rw = (W0_); rw < 4 * FF2 + 2 * D; rw += (NW_)) { \
                    const bool up = rw < 4 * FF2; const int jq = up ? 0 : (rw - 4 * FF2) / D; const int lw = up ? rw / FF2 : 2 + jq, r = up ? rw % FF2 : (rw - 4 * FF2) % D; \
                    const bf16_t* Brow = (up ? Wb + we_up(lw) : Wb + we_q(jq)) + (size_t)r * D + 16 * lane; \
                    const float* shp = MOD + (size_t)lw * 8 * 6144 + (up ? 3072 : 0) + 16 * lane; \
                    float* dst = up ? (float*)(ws + WS_BIASUP) + (size_t)lw * 8 * FF2 + r : (float*)(ws + WS_BIASQ) + (size_t)jq * 8 * D + r; const int dstr = up ? FF2 : D; \
                    const u32x4 w0 = *(const u32x4*)Brow, w1 = *(const u32x4*)(Brow + 8); float wv[16]; \
_Pragma("unroll") \
                    for (int e = 0; e < 4; ++e) { wv[2 * e] = __uint_as_float(w0[e] << 16); wv[2 * e + 1] = __uint_as_float(w0[e] & 0xffff0000u); wv[8 + 2 * e] = __uint_as_float(w1[e] << 16); wv[9 + 2 * e] = __uint_as_float(w1[e] & 0xffff0000u); } \
                    for (int b = 0; b < 8; ++b) { float sacc = 0.f; \
_Pragma("unroll") \
                        for (int e = 0; e < 4; ++e) { const f32x4 sv = *(const f32x4*)(shp + (size_t)b * 6144 + 4 * e); sacc += (wv[4 * e] * sv[0] + wv[4 * e + 1] * sv[1]) + (wv[4 * e + 2] * sv[2] + wv[4 * e + 3] * sv[3]); } \
                        sacc = wave_sum_dpp(sacc); if (lane == 0) dst[(size_t)b * dstr] = sacc; } \
                } \
} while (0)
    for (int l = 0; l < 4; ++l) {
        const float* xin = (l == 0) ? INP(I_X) : out;
        const float* modl = MOD + (size_t)l * 8 * 6144;
        if (l < 2) {
            norm_phase(xin, INP(I_N1) + (size_t)l * D, modl, 0, 1024, H, nullptr, nullptr, gw, NGW, lane);
            if (l == 0) {
                if (G <= NB * 16) BIAS_WORK(gw, NGW);
            }
            SYNC();
        }
        bf16_t* mixo;
        if (l < 2) {
            bf16_t* Rb = (bf16_t*)(ws + WS_R); bf16_t* Kb = (bf16_t*)(ws + WS_K); bf16_t* Vb = (bf16_t*)(ws + (l == 0 ? WS_VF : WS_V1)); bf16_t* Lb = (bf16_t*)(ws + WS_L);
            {
                pg8::Gemm g; g.A = (const char*)(H + (size_t)8 * D); g.Bt = Wb + we_rkvl(l); g.K = 2048; g.lda = D;
                pg8::StaticOrder So; So.init(T / 256, (int)NRKVL / 256, OPQ(G), OPQ(bx));
                EpiRkvL E{Rb, Kb, Vb, Lb};
                pg8::gemm_phase<EpiRkvL, pg8::StaticOrder, true, true, 16, false, true>(lds, g, So, E);
            }
            SYNC();
            if (DBG == 1) { dbg_dump(out, Rb, Kb, Vb, Lb, gtid, NTOT); return; }
            {
                ScanP P; P.R = Rb; P.K = Kb; P.V = Vb; P.VF = (const bf16_t*)(ws + WS_VF); P.L = Lb; P.Y = Rb; P.LB = Wb + we_lb(l);
                P.w0 = INP(I_W0) + (size_t)l * D; P.a0 = INP(I_A0) + (size_t)l * D; P.v0 = INP(I_V0); P.kk = INP(I_KK) + (size_t)l * D; P.ka = INP(I_KA) + (size_t)l * D;
                P.rk = INP(I_RK) + (size_t)l * D; P.lnw = INP(I_LNW) + (size_t)l * D; P.lnb = INP(I_LNB) + (size_t)l * D; P.vres = (l == 1);
                scan_phase(lds, P, OPQ(G));
                if (l == 0 && OPQ(G) > NB * 16 && OPQ(bx) >= NB * 16) BIAS_WORK((bx - NB * 16) * NWAVES + wave, (G - NB * 16) * NWAVES);
            }
            mixo = Rb;
            if (DBG == 2) { SYNC(); return; }
        } else {
            const int j = l - 2;
            bf16_t* Qb = (bf16_t*)(ws + WS_Q); bf16_t* KSb = (bf16_t*)(ws + WS_KS); bf16_t* VSb = (bf16_t*)(ws + WS_VS); bf16_t* O0 = (bf16_t*)(ws + WS_O0); bf16_t* O1 = (bf16_t*)(ws + WS_O1);
            for (int gi = 0; gi < (j == 0 ? 2 : 1); ++gi) {
                pg8::Gemm g; g.A = (const char*)((gi == 0 ? H : (bf16_t*)(ws + WS_HK)) + (size_t)8 * D); g.Bt = gi == 0 ? Wb + we_q(j) : Wb + WE_KV; g.K = D; g.lda = D;
                pg8::StaticOrder So; So.init(T / 256, gi == 0 ? 4 : 8, OPQ(G), OPQ(bx));
                EpiRope E{ws, (unsigned)(gi == 0 ? WS_Q : WS_KS), (unsigned)WS_VS, (unsigned)(WS_SS + (l == 3 ? 4 : 5) * (size_t)T * 4), (unsigned)(WS_BIASQ + (size_t)j * 8 * D * 4), gi == 0 ? attn_body::C2 : 1.f, 1, gi == 0 ? 1 : 0};
                pg8::gemm_phase<EpiRope, pg8::StaticOrder, true, true, 16, false, false>(lds, g, So, E);
            }
            SYNC();
            {
                const int G_ = OPQ(G), bx_ = OPQ(bx); const int vcu = (G_ % 8 == 0) ? (bx_ % 8) * (G_ / 8) + bx_ / 8 : bx_;
                for (int combo = vcu; combo < 256; combo += G_) { const int b = combo >> 5, vhd = (combo >> 1) & 15, vh = combo & 1;
                    for (int qb = S / 256 - 1; qb >= 0; --qb)
                        attn_body::attn_unit<8>(b, vhd * 64, (vhd >> 1) * 128 + vh * 64, qb, (const attn_body::bf16*)Qb, (const attn_body::bf16*)KSb, (const attn_body::bf16*)VSb, (attn_body::bf16*)((vhd & 1) ? O1 : O0), (char*)lds_raw); }
            }
            SYNC();
            combine_phase(O0, O1, INP(I_LAM) + (size_t)j * 256, INP(I_SUBLN) + (size_t)j * 128, 0.8f - 0.6f * expf(-0.3f * (float)l), gw, NGW, lane);
            mixo = O0;
        }
        SYNC();
        for (int pass = 0; pass < 2; ++pass) {
            const size_t act_off = l == 0 ? WS_ACT_R : (l == 1 ? WS_A : WS_ACT_B);
            bf16_t* ACT = (bf16_t*)(ws + act_off);
            if (pass) {
                {
                    pg8::Gemm g; g.A = (const char*)(H + (size_t)6 * D); g.Bt = Wb + we_up(l); g.K = D; g.lda = D;
                    pg8::StaticOrder So; So.init(NB * 17, FF2 / 256, OPQ(G), OPQ(bx));
                    EpiUp E{ws, INP(I_CW) + (size_t)l * 3 * FF2, INP(I_CB) + (size_t)l * FF2, (unsigned)act_off, (unsigned)(WS_SS + (size_t)l * T * 4), (unsigned)(WS_BIASUP + (size_t)l * 8 * FF2 * 4)};
                    pg8::gemm_phase<EpiUp, pg8::StaticOrder, true, true, 17, true, false>(lds, g, So, E);
                }
                SYNC();
                if (DBG == 4) { for (size_t i = gtid; i < (size_t)T * D; i += NTOT) out[i] = bf2f(ACT[(i >> 10) * FF + (i & 1023)]) + bf2f(ACT[(i >> 10) * FF + 1024 + (i & 1023)]) + bf2f(ACT[(i >> 10) * FF + 1792 + (i & 1023)]); return; }
            }
            {
                pg8::Gemm g; g.A = (const char*)(pass ? ACT : mixo); g.Bt = pass ? Wb + we_dn(l) : (l < 2 ? Wb + we_woa(l) : Wb + we_ob(l - 2)); g.K = pass ? FF : D; g.lda = g.K;
                pg8::StaticOrder So; So.init(T / 256, 4, OPQ(G), OPQ(bx));
                const int nx = pass == 0 ? 1 : (l == 1 ? 2 : (l == 2 ? 1 : 0));
                EpiRes E{(l == 0 && pass == 0) ? INP(I_X) : out, out, ws, pass == 0 ? INP(I_N2) + (size_t)l * D : INP(I_N1) + (size_t)(l + 1 < 4 ? l + 1 : 3) * D, (unsigned)(WS_MOD + ((size_t)l * 8 * 6144 + (pass ? 5120 : 2048)) * 4),
                         (unsigned)(WS_MOD + (pass == 0 ? (size_t)l * 8 * 6144 + 4096 : (size_t)(l + 1 < 4 ? l + 1 : 3) * 8 * 6144 + 1024) * 4), (unsigned)(WS_SS + (pass == 0 ? (size_t)l : (l == 2 ? (size_t)4 : (size_t)5)) * T * 4), nx};
                pg8::gemm_phase<EpiRes, pg8::StaticOrder, true, true, 0, false, false>(lds, g, So, E);
            }
            SYNC();
            if (DBG == 3 && pass == 0) return;
            if (DBG == 5 && pass == 1) return;
            if (DBG == 6 && pass == 1 && l == 1) return;
            if (DBG == 7 && pass == 1 && l == 2) return;
        }
    }
    final_norm_phase(out, INP(I_FN), gw, NGW, lane);
#undef tid
#undef lane
#undef gtid
}

extern "C" void kernel_launch(void* const* d_in, const int* in_sizes, int n_in, void* d_out, int out_size, void* d_ws, size_t ws_size, hipStream_t stream) {
    static int grid = 0;
    if (grid == 0) {
        if (n_in != 36 || out_size != T * D || ws_size < WS_END) { fprintf(stderr, "kernel_launch: unexpected problem (n_in %d, out %d, ws %zu < %zu)\n", n_in, out_size, ws_size, (size_t)WS_END); grid = -1; return; }
        int dev = 0, cus = 0, per_cu = 0;
        hipGetDevice(&dev); hipDeviceGetAttribute(&cus, hipDeviceAttributeMultiprocessorCount, dev);
        if (hipFuncSetAttribute((const void*)yoco_fwd, hipFuncAttributeMaxDynamicSharedMemorySize, LDS_BYTES) != hipSuccess) { fprintf(stderr, "kernel_launch: hipFuncSetAttribute failed\n"); grid = -1; return; }
        if (hipOccupancyMaxActiveBlocksPerMultiprocessor(&per_cu, (const void*)yoco_fwd, NTHR, LDS_BYTES) != hipSuccess || per_cu < 1) { fprintf(stderr, "kernel_launch: occupancy query failed (%d)\n", per_cu); (void)hipGetLastError(); per_cu = 1; }
        grid = cus * per_cu;
    }
    if (grid < 0) return;
    if (hipMemsetAsync((char*)d_ws + WS_CTL, 0, 1048576, stream) != hipSuccess) { fprintf(stderr, "kernel_launch: memset failed\n"); return; }
    Args a{};
    for (int i = 0; i < 36; ++i) a.in[i] = (const float*)d_in[i];
    a.out = (float*)d_out; a.ws = (unsigned char*)d_ws;
    void* args[] = {&a};
    hipError_t e = hipLaunchCooperativeKernel((const void*)yoco_fwd, dim3(grid), dim3(NTHR), args, LDS_BYTES, stream);
    if (e != hipSuccess) fprintf(stderr, "kernel_launch: cooperative launch failed: %s (grid %d)\n", hipGetErrorString(e), grid);
}
```

```cpp
#include <hip/hip_runtime.h>
#include <hip/hip_cooperative_groups.h>
#include <cstdio>
#include <cstdint>
namespace cg = cooperative_groups;
namespace pg8 {
#define PG8_LAS __attribute__((address_space(3)))
typedef unsigned short bf16_t;
typedef short bf16x8 __attribute__((ext_vector_type(8)));
typedef float f32x4 __attribute__((ext_vector_type(4)));
typedef unsigned u32x4 __attribute__((ext_vector_type(4)));
constexpr int BM = 256, BK = 64, HALF = 128, HTB = HALF * BK * 2  , STAGE_BYTES = 8 * HTB, NXCD = 8, WGM = 8;

__host__ __device__ __forceinline__ int lds_byte(int r, int c) { const int st = (r >> 4) * 2 + (c >> 5), rr = r & 15, cc = c & 31, ob = rr * 64 + cc * 2; return st * 1024 + (ob ^ (((ob >> 9) & 1) << 5)); }
__host__ __device__ __forceinline__ void stage_rc(int b, int& R, int& C) { const int st = b / 1024, sb = b % 1024, swz = sb ^ (((sb >> 9) & 1) << 5); R = (st >> 1) * 16 + swz / 64; C = (st & 1) * 32 + (swz % 64) / 2; }
__host__ __device__ __forceinline__ int perm32(int rho) { const int n = rho >> 4, i = rho & 15; return 8 * (i >> 2) + 4 * n + (i & 3); }

struct Unit { int pm, pn; };
struct Gemm { const char* A; const bf16_t* Bt; int K, lda; };

struct StaticOrder {
    int nM, nN, nwg, G, c;
    __host__ __device__ void init(int nM_, int nN_, int G_, int c_) { nM = nM_; nN = nN_; nwg = nM * nN; G = G_; c = c_; }
    __host__ __device__ bool next(int i, Unit& u) const {
        const long L = (long)i * G + c; if (L >= nwg) return false;
        int wgid = (int)L; { const int q = nwg / NXCD, r = nwg % NXCD, xcd = wgid % NXCD, off = wgid / NXCD; wgid = (xcd < r ? xcd * (q + 1) : r * (q + 1) + (xcd - r) * q) + off; }
        const int nig = WGM * nN, gid = wgid / nig, fm = gid * WGM, gsz = (nM - fm) < WGM ? (nM - fm) : WGM;
        u.pm = fm + ((wgid % nig) % gsz); u.pn = (wgid % nig) / gsz; return true;
    }
    __device__ __forceinline__ void a_ready(const Unit&) const {}
    __device__ __forceinline__ void done(const Unit&) const {}
};

__device__ __forceinline__ unsigned cvt_pk_bf16(float lo, float hi) { unsigned r; asm volatile("v_cvt_pk_bf16_f32 %0, %1, %2" : "=v"(r) : "v"(lo), "v"(hi)); return r; }
typedef float f32x2 __attribute__((ext_vector_type(2)));
__device__ __forceinline__ f32x2 gelu_pk(f32x2 v) {
    const f32x2 av = __builtin_elementwise_abs(v), d = av * 0.2316418882f + 1.0f;
    f32x2 t; t.x = __builtin_amdgcn_rcpf(d.x); t.y = __builtin_amdgcn_rcpf(d.y);
    f32x2 q = t * 0.5307027145f + (-0.7265760135f); q = q * t + 0.7107068705f; q = q * t + (-0.142248368f); q = q * t + 0.127414796f; q = q * t;
    const f32x2 s = (v * v) * (-0.72134752044f);
    f32x2 e; e.x = __builtin_amdgcn_exp2f(s.x); e.y = __builtin_amdgcn_exp2f(s.y);
    const f32x2 m = v * (q * e), r = v - m;
    f32x2 o; o.x = v.x < 0.f ? m.x : r.x; o.y = v.y < 0.f ? m.y : r.y; return o;
}

template <int ACT  > struct EpiBf16 {
    static constexpr bool PERM = true, AFTER_DRAIN = false; static_assert(ACT == 0 || ACT == 1, "EpiBf16: ACT is 0 (none) or 1 (gelu_pk)");
    bf16_t* O; int ldc; const float* bias; int split_cols; size_t split_stride; float scale0;
    __device__ __forceinline__ void operator()(const f32x4 (&acc)[2][2][4][2], const Unit& u, int wr, int wc, int fr, int fq) const {
        const int row0 = u.pm * BM + wr * 64 + fr; int colt = u.pn * BM; bf16_t* base = O;
        float sc = 1.f; if (split_cols) { const int t = colt / split_cols; base += (size_t)t * split_stride; colt -= t * split_cols; if (t == 0) sc = scale0; }
        const int col0 = colt + wc * 32 + 8 * fq, bcol0 = u.pn * BM + wc * 32 + 8 * fq;
        f32x4 bv[2][2];
#pragma unroll
        for (int bj = 0; bj < 2; ++bj)
#pragma unroll
            for (int n = 0; n < 2; ++n) bv[bj][n] = bias ? *(const f32x4*)(bias + bcol0 + bj * HALF + 4 * n) : (f32x4){0.f, 0.f, 0.f, 0.f};
#pragma unroll
        for (int ai = 0; ai < 2; ++ai)
#pragma unroll
            for (int m = 0; m < 4; ++m) { bf16_t* rowp = base + (size_t)(row0 + ai * HALF + m * 16) * ldc + col0;
#pragma unroll
                for (int bj = 0; bj < 2; ++bj) { f32x4 v0 = acc[ai][bj][m][0] + bv[bj][0], v1 = acc[ai][bj][m][1] + bv[bj][1];
                    if (ACT == 1) { f32x2 a = gelu_pk((f32x2){v0[0], v0[1]}), b = gelu_pk((f32x2){v0[2], v0[3]}), c = gelu_pk((f32x2){v1[0], v1[1]}), d = gelu_pk((f32x2){v1[2], v1[3]});
                        v0 = (f32x4){a.x, a.y, b.x, b.y}; v1 = (f32x4){c.x, c.y, d.x, d.y}; }
                    v0 = v0 * sc; v1 = v1 * sc; u32x4 w; w.x = cvt_pk_bf16(v0[0], v0[1]); w.y = cvt_pk_bf16(v0[2], v0[3]); w.z = cvt_pk_bf16(v1[0], v1[1]); w.w = cvt_pk_bf16(v1[2], v1[3]);
                    *(u32x4*)(rowp + bj * HALF) = w; } }
    }
};
template <class Epi, class Sched, bool ALIGN_EPI, bool SP2, int UPB  , bool HALO, bool WRAP>
__device__ __forceinline__ void gemm_phase(PG8_LAS unsigned char* lds, const Gemm g, const Sched& S, const Epi& E) {
    int tid_o_ = threadIdx.x; asm volatile("" : "+v"(tid_o_)); const int tid = tid_o_, wid = __builtin_amdgcn_readfirstlane(tid >> 6), lane = tid & 63, wr = wid >> 2, wc = wid & 3, fr = lane & 15, fq = lane >> 4;
    const int K = g.K, nt = K / BK;
    unsigned voffA[2], voffB[2];
#pragma unroll
    for (int i = 0; i < 2; ++i) { int R, C; stage_rc(tid * 16 + i * 8192, R, C); const int Rb = Epi::PERM ? ((R & ~31) + perm32(R & 31)) : R;
        const int Ra = HALO ? (R - 2 * (R >> 6)) : R; voffA[i] = (unsigned)(Ra * g.lda + C) * 2u; voffB[i] = (unsigned)(Rb * K + C) * 2u; }
    const size_t kstep = (size_t)(BK * 2);
    const size_t hstep = (size_t)HALF * K * 2;
    const size_t hstepA = (size_t)((HALO ? 124 : 128) * g.lda * 2);
#define PG8_KOFFA(t) ((long)(t) * (long)kstep + ((WRAP && (t) >= 16) ? -(long)(16 * 128 + 2048) : 0l))
#define PG8_APTR(pm) (UPB ? (g.A + (size_t)((pm) / (UPB ? UPB : 1)) * (size_t)(4104 * 2048) + (size_t)((pm) % (UPB ? UPB : 1)) * (size_t)((HALO ? 248 : 256) * 2048)) : (g.A + (size_t)(pm) * (size_t)(256 * 2) * (size_t)g.lda))
    const size_t tstep = 2 * hstep;
    const unsigned ldsw = (unsigned)wid * 1024u;
    const int aoff = lds_byte(wr * 64 + fr, fq * 8), boff = lds_byte(wc * 32 + fr, fq * 8);
#define PG8_SA(b, h) (((b) * 2 + (h)) * HTB)
#define PG8_SB(b, h) ((4 + (b) * 2 + (h)) * HTB)
#define PG8_STAGE(bufoff, gbase, voff) do { _Pragma("unroll") for (int _i = 0; _i < 2; ++_i) \
        __builtin_amdgcn_global_load_lds((const unsigned*)((const char*)(gbase) + (voff)[_i]), (PG8_LAS unsigned*)(lds + (bufoff) + ldsw + _i * 8192), 16, 0, 0); } while (0)
#define PG8_LDA(dst, b, h) do { _Pragma("unroll") for (int m = 0; m < 4; ++m) _Pragma("unroll") for (int k = 0; k < 2; ++k) dst[m][k] = *(const PG8_LAS bf16x8*)(lds + PG8_SA(b, h) + aoff + m * 2048 + k * 1024); } while (0)
#define PG8_LDB(dst, b, h) do { _Pragma("unroll") for (int n = 0; n < 2; ++n) _Pragma("unroll") for (int k = 0; k < 2; ++k) dst[n][k] = *(const PG8_LAS bf16x8*)(lds + PG8_SB(b, h) + boff + n * 2048 + k * 1024); } while (0)
#define PG8_MMA(ai, bj, At, Bt) do { __builtin_amdgcn_s_setprio(1); _Pragma("unroll") for (int m = 0; m < 4; ++m) _Pragma("unroll") for (int n = 0; n < 2; ++n) _Pragma("unroll") for (int k = 0; k < 2; ++k) \
        acc[ai][bj][m][n] = __builtin_amdgcn_mfma_f32_16x16x32_bf16(Bt[n][k], At[m][k], acc[ai][bj][m][n], 0, 0, 0); __builtin_amdgcn_s_setprio(0); } while (0)
#define PG8_WAIT_V(n) asm volatile("s_waitcnt vmcnt(" #n ")" ::: "memory")
#define PG8_WAIT_L(n) asm volatile("s_waitcnt lgkmcnt(" #n ")" ::: "memory")
#define PG8_BAR __builtin_amdgcn_s_barrier()
#define PG8_SCHED __builtin_amdgcn_sched_barrier(0)
    Unit cur, nxt; int ui = 0;
    if (!S.next(0, cur)) return;
    f32x4 acc[2][2][4][2];
#pragma unroll
    for (int a = 0; a < 2; ++a)
#pragma unroll
        for (int b = 0; b < 2; ++b)
#pragma unroll
            for (int m = 0; m < 4; ++m)
#pragma unroll
                for (int n = 0; n < 2; ++n) acc[a][b][m][n] = (f32x4){0.f, 0.f, 0.f, 0.f};
    bf16x8 At[4][2], B0[2][2], B1[2][2];
    const char* cA = PG8_APTR(cur.pm); const char* cB = (const char*)g.Bt + (size_t)cur.pn * tstep;
    S.a_ready(cur);
    if constexpr (SP2) {
        PG8_STAGE(PG8_SB(0, 0), cB, voffB); PG8_STAGE(PG8_SB(0, 1), cB + hstep, voffB); PG8_STAGE(PG8_SA(0, 0), cA, voffA); PG8_STAGE(PG8_SA(0, 1), cA + hstepA, voffA);
        if (wr == 1) PG8_BAR;
        PG8_WAIT_V(2); PG8_BAR;
        PG8_STAGE(PG8_SB(1, 0), cB + kstep, voffB); PG8_STAGE(PG8_SA(1, 0), cA + kstep, voffA); PG8_STAGE(PG8_SB(1, 1), cB + hstep + kstep, voffB);
        PG8_WAIT_V(6); PG8_BAR;
    } else {
        PG8_STAGE(PG8_SB(0, 0), cB, voffB); PG8_STAGE(PG8_SA(0, 0), cA, voffA); PG8_STAGE(PG8_SB(0, 1), cB + hstep, voffB); PG8_STAGE(PG8_SA(0, 1), cA + hstepA, voffA);
        if (wr == 1) PG8_BAR;
        PG8_WAIT_V(4); PG8_BAR;
        PG8_STAGE(PG8_SB(1, 0), cB + kstep, voffB); PG8_STAGE(PG8_SA(1, 0), cA + kstep, voffA); PG8_STAGE(PG8_SB(1, 1), cB + hstep + kstep, voffB);
        PG8_WAIT_V(6); PG8_BAR;
    }
    for (;;) {
        const bool has_next = S.next(ui + 1, nxt);
        const char* nA = has_next ? PG8_APTR(nxt.pm) : cA; const char* nB = has_next ? (const char*)g.Bt + (size_t)nxt.pn * tstep : cB;
        for (int t = 0; t < nt; t += 2) {
            const bool last = (t == nt - 2);
            const char* a1 = cA + PG8_KOFFA(t + 1);
            const char* a2 = last ? nA : cA + PG8_KOFFA(t + 2); const char* b2 = last ? nB : cB + (size_t)(t + 2) * kstep;
            const char* a3 = a2 + kstep; const char* b3 = b2 + kstep;
            if (last && has_next) S.a_ready(nxt);
            if constexpr (SP2) {
            PG8_LDB(B0, 0, 0); PG8_LDB(B1, 0, 1); PG8_SCHED; PG8_LDA(At, 0, 0); PG8_STAGE(PG8_SA(1, 1), a1 + hstepA, voffA);
            PG8_WAIT_V(8); PG8_WAIT_L(0); PG8_BAR; PG8_MMA(0, 0, At, B0); PG8_MMA(0, 1, At, B1); PG8_BAR; PG8_SCHED;
            PG8_LDA(At, 0, 1); PG8_STAGE(PG8_SB(0, 0), b2, voffB); PG8_STAGE(PG8_SB(0, 1), b2 + hstep, voffB); PG8_STAGE(PG8_SA(0, 0), a2, voffA);
            PG8_WAIT_V(8); PG8_WAIT_L(0); PG8_BAR; PG8_MMA(1, 0, At, B0); PG8_MMA(1, 1, At, B1); PG8_BAR; PG8_SCHED;
            PG8_LDB(B0, 1, 0); PG8_LDB(B1, 1, 1); PG8_SCHED; PG8_LDA(At, 1, 0); PG8_STAGE(PG8_SA(0, 1), a2 + hstepA, voffA);
            PG8_WAIT_V(8); PG8_WAIT_L(0); PG8_BAR; PG8_MMA(0, 0, At, B0); PG8_MMA(0, 1, At, B1); PG8_BAR; PG8_SCHED;
            PG8_LDA(At, 1, 1); PG8_STAGE(PG8_SB(1, 0), b3, voffB); PG8_STAGE(PG8_SB(1, 1), b3 + hstep, voffB); PG8_STAGE(PG8_SA(1, 0), a3, voffA);
            PG8_WAIT_V(8); PG8_WAIT_L(0); PG8_BAR; PG8_MMA(1, 0, At, B0); PG8_MMA(1, 1, At, B1); PG8_BAR; PG8_SCHED;
            } else {
            PG8_LDB(B0, 0, 0); PG8_SCHED; PG8_LDA(At, 0, 0); PG8_STAGE(PG8_SA(1, 1), a1 + hstepA, voffA);
            PG8_WAIT_L(8); PG8_BAR; PG8_WAIT_L(0); PG8_MMA(0, 0, At, B0); PG8_BAR; PG8_SCHED;
            PG8_LDB(B1, 0, 1); PG8_STAGE(PG8_SB(0, 0), b2, voffB);
            PG8_BAR; PG8_WAIT_L(0); PG8_MMA(0, 1, At, B1); PG8_BAR;
            PG8_LDA(At, 0, 1); PG8_STAGE(PG8_SA(0, 0), a2, voffA);
            PG8_BAR; PG8_WAIT_L(0); PG8_MMA(1, 0, At, B0); PG8_BAR; PG8_SCHED;
            PG8_STAGE(PG8_SB(0, 1), b2 + hstep, voffB);
            PG8_WAIT_V(6); PG8_BAR; PG8_MMA(1, 1, At, B1); PG8_BAR;
            PG8_LDB(B0, 1, 0); PG8_SCHED; PG8_LDA(At, 1, 0); PG8_STAGE(PG8_SA(0, 1), a2 + hstepA, voffA);
            PG8_WAIT_L(8); PG8_BAR; PG8_WAIT_L(0); PG8_MMA(0, 0, At, B0); PG8_BAR; PG8_SCHED;
            PG8_LDB(B1, 1, 1); PG8_STAGE(PG8_SB(1, 0), b3, voffB);
            PG8_BAR; PG8_WAIT_L(0); PG8_MMA(0, 1, At, B1); PG8_BAR;
            PG8_LDA(At, 1, 1); PG8_STAGE(PG8_SA(1, 0), a3, voffA);
            PG8_BAR; PG8_WAIT_L(0); PG8_MMA(1, 0, At, B0); PG8_BAR; PG8_SCHED;
            PG8_STAGE(PG8_SB(1, 1), b3 + hstep, voffB);
            PG8_WAIT_V(6); PG8_BAR; PG8_MMA(1, 1, At, B1); PG8_BAR;
            }
        }
        if constexpr (ALIGN_EPI) { if (wr == 0) PG8_BAR; }
        if constexpr (!Epi::AFTER_DRAIN) { E(acc, cur, wr, wc, fr, fq); S.done(cur); }
        if (!has_next) break;
#pragma unroll
        for (int a = 0; a < 2; ++a)
#pragma unroll
            for (int b = 0; b < 2; ++b)
#pragma unroll
                for (int m = 0; m < 4; ++m)
#pragma unroll
                    for (int n = 0; n < 2; ++n) acc[a][b][m][n] = (f32x4){0.f, 0.f, 0.f, 0.f};
        cur = nxt; cA = nA; cB = nB; ++ui;
        if constexpr (ALIGN_EPI) { if (wr == 1) PG8_BAR; }
    }
    PG8_WAIT_V(0);
    if constexpr (!ALIGN_EPI) { if (wr == 0) PG8_BAR; }
    PG8_BAR;
    if constexpr (Epi::AFTER_DRAIN) { E.fused(acc, cur, wr, wc, fr, fq, lds, wid, lane); S.done(cur); }
#undef PG8_SA
#undef PG8_KOFFA
#undef PG8_APTR
#undef PG8_SB
#undef PG8_STAGE
#undef PG8_LDA
#undef PG8_LDB
#undef PG8_MMA
#undef PG8_WAIT_V
#undef PG8_WAIT_L
#undef PG8_BAR
#undef PG8_SCHED
}
}
#include <hip/hip_bf16.h>
#include <cmath>
namespace attn_body {
using bf16=__hip_bfloat16;
using bf16x8=__attribute__((ext_vector_type(8)))short;
using s16x4=__attribute__((ext_vector_type(4)))short;
using f32x16=__attribute__((ext_vector_type(16)))float;
using u32x4=__attribute__((ext_vector_type(4)))unsigned;
constexpr int BATCH=8,NHEAD=16,SEQ=4096,D=64,DM=NHEAD*D;
constexpr int NW=8,QBLK=32,QB=QBLK*NW,KVBLK=64,NQB=SEQ/QB;
constexpr int ATTN_PITCH=DM, ATTN_UNIT_ROWS=QB;
__device__ __forceinline__ int crow(int r,int hi){return (r&3)+8*(r>>2)+4*hi;}
#define SBAR() __builtin_amdgcn_sched_barrier(0)
__device__ __forceinline__ void cmask(f32x16&p0,f32x16&p1,int jb,int qrel,int hi){
  const float NEG=-INFINITY; int kb=64*jb+4*hi;
  #pragma unroll
  for(int r=0;r<16;++r){int kv=kb+(r&3)+8*(r>>2); if(kv>qrel)p0[r]=NEG; if(kv+32>qrel)p1[r]=NEG;}
}

constexpr int NSLOT=3, SLOTB=8192;
constexpr int LDS_K=0, LDS_V=NSLOT*SLOTB, LDS_WS=2*NSLOT*SLOTB, LDS_OST=LDS_WS+NW*64*4, LDS_BYTES=LDS_OST+NW*4096;
constexpr float C2=0.125f*1.4426950408889634f;
__device__ __forceinline__ void glds16(const void*gsrc,unsigned lds_dst){unsigned keep;
  asm volatile("s_mov_b32 %0, m0\n\ts_mov_b32 m0, %2\n\ts_nop 0\n\tglobal_load_lds_dwordx4 %1, off\n\ts_mov_b32 m0, %0":"=&s"(keep):"v"(gsrc),"s"(lds_dst):"memory");}
__device__ __forceinline__ float max3f(float a,float b,float c){float r;asm("v_max3_f32 %0, %1, %2, %3":"=v"(r):"v"(a),"v"(b),"v"(c));return r;}
__device__ __forceinline__ float max2f(float a,float b){float r;asm("v_max_f32_e32 %0, %1, %2":"=v"(r):"v"(a),"v"(b));return r;}
__device__ __forceinline__ float fadd_s(float a,float b){float r;asm("v_add_f32_e32 %0, %1, %2":"=v"(r):"v"(a),"v"(b));return r;}
__device__ __forceinline__ float fsub_s(float a,float b){float r;asm("v_sub_f32_e32 %0, %1, %2":"=v"(r):"v"(a),"v"(b));return r;}
typedef float f32x2_t __attribute__((ext_vector_type(2))); typedef __bf16 bf16x2_t __attribute__((ext_vector_type(2)));
__device__ __forceinline__ unsigned cvtpk_s(float lo,float hi){f32x2_t v={lo,hi};bf16x2_t b=__builtin_convertvector(v,bf16x2_t);return __builtin_bit_cast(unsigned,b);}
#define WAIT_BAR(N) asm volatile("s_waitcnt vmcnt(" #N ") lgkmcnt(0)\n\ts_barrier":::"memory")

__device__ __forceinline__ void qkt(f32x16&p0,f32x16&p1,const char*Kslot,const bf16x8*qr,const f32x16&negm,int r32,int hi){
  const char*kb=Kslot+hi*1024+r32*16;
  #pragma unroll
  for(int d0=0;d0<4;++d0){
    const bf16x8 b0=*reinterpret_cast<const bf16x8*>(kb+d0*2048);
    const bf16x8 b1=*reinterpret_cast<const bf16x8*>(kb+d0*2048+512);
    if(d0==0){p0=__builtin_amdgcn_mfma_f32_32x32x16_bf16(b0,qr[0],negm,0,0,0);p1=__builtin_amdgcn_mfma_f32_32x32x16_bf16(b1,qr[0],negm,0,0,0);}
    else{p0=__builtin_amdgcn_mfma_f32_32x32x16_bf16(b0,qr[d0],p0,0,0,0);p1=__builtin_amdgcn_mfma_f32_32x32x16_bf16(b1,qr[d0],p1,0,0,0);}}
}
typedef __attribute__((address_space(3))) const char* lds_cptr;
typedef short v4i16_t __attribute__((ext_vector_type(4)));
__device__ __forceinline__ void kload8(bf16x8*kf,lds_cptr kp){
  kf[0]=*(const __attribute__((address_space(3))) bf16x8*)(kp);      kf[1]=*(const __attribute__((address_space(3))) bf16x8*)(kp+512);
  kf[2]=*(const __attribute__((address_space(3))) bf16x8*)(kp+2048); kf[3]=*(const __attribute__((address_space(3))) bf16x8*)(kp+2560);
  kf[4]=*(const __attribute__((address_space(3))) bf16x8*)(kp+4096); kf[5]=*(const __attribute__((address_space(3))) bf16x8*)(kp+4608);
  kf[6]=*(const __attribute__((address_space(3))) bf16x8*)(kp+6144); kf[7]=*(const __attribute__((address_space(3))) bf16x8*)(kp+6656);
}
__device__ __forceinline__ void kload2(bf16x8*kf,lds_cptr kp,int j){ kf[2*j]=*(const __attribute__((address_space(3))) bf16x8*)(kp+j*2048); kf[2*j+1]=*(const __attribute__((address_space(3))) bf16x8*)(kp+j*2048+512); }
__device__ __forceinline__ s16x4 vtr(lds_cptr p){ return __builtin_bit_cast(s16x4,__builtin_amdgcn_ds_read_tr16_b64_v4i16((__attribute__((address_space(3))) v4i16_t*)p)); }
__device__ __forceinline__ float rowmax(const f32x16&p0,const f32x16&p1){
  float a=max3f(p0[0],p0[1],p1[0]),b=max3f(p0[2],p0[3],p1[1]);a=max3f(a,p1[2],p1[3]);
  #pragma unroll
  for(int r=4;r<16;r+=4){a=max3f(a,p0[r],p0[r+1]);b=max3f(b,p0[r+2],p0[r+3]);a=max3f(a,p1[r],p1[r+1]);b=max3f(b,p1[r+2],p1[r+3]);}
  const float m=max2f(a,b);
  auto rr=__builtin_amdgcn_permlane32_swap(__float_as_uint(m),__float_as_uint(m),false,false);
  return max2f(__uint_as_float(rr[0]),__uint_as_float(rr[1]));
}
__device__ __forceinline__ void pv(f32x16*o,int vb,bf16x8 pa0,bf16x8 pa1,bf16x8 pa2,bf16x8 pa3){
  #pragma unroll
  for(int d0=0;d0<2;++d0){s16x4 lo[4],hi[4];
    #pragma unroll
    for(int ks=0;ks<4;++ks){
      asm volatile("ds_read_b64_tr_b16 %0,%1 offset:%c2":"=&v"(lo[ks]):"v"(vb),"i"(d0*4096+ks*1024):"memory");
      asm volatile("ds_read_b64_tr_b16 %0,%1 offset:%c2":"=&v"(hi[ks]):"v"(vb),"i"(d0*4096+ks*1024+512):"memory");}
    asm volatile("s_waitcnt lgkmcnt(0)":::"memory");SBAR();
    #define PK(k) (bf16x8){lo[k][0],lo[k][1],lo[k][2],lo[k][3],hi[k][0],hi[k][1],hi[k][2],hi[k][3]}
    o[d0]=__builtin_amdgcn_mfma_f32_32x32x16_bf16(pa0,PK(0),o[d0],0,0,0);
    o[d0]=__builtin_amdgcn_mfma_f32_32x32x16_bf16(pa1,PK(1),o[d0],0,0,0);
    o[d0]=__builtin_amdgcn_mfma_f32_32x32x16_bf16(pa2,PK(2),o[d0],0,0,0);
    o[d0]=__builtin_amdgcn_mfma_f32_32x32x16_bf16(pa3,PK(3),o[d0],0,0,0);
    #undef PK
  }
}

#ifndef ATTN_STORE16
#define ATTN_STORE16(p,v) (*(u32x4*)(p)=(v))
#endif
template<int THRL> __device__ __forceinline__ void attn_unit(int b,int cq,int cv,int qb,const bf16*Q,const bf16*__restrict__ K,const bf16*__restrict__ V,bf16*O,char*shm){
  int tid_o_=threadIdx.x; asm volatile("":"+v"(tid_o_)); const int tid=tid_o_,lane=tid&63,r32=lane&31,hi=lane>>5; const int wid=__builtin_amdgcn_readfirstlane(tid>>6);
  const long rowbase=(long)b*SEQ; const int q0=qb*QB;
  const bf16*Qw=Q+(rowbase+q0+wid*QBLK)*DM+cq;
  const bf16*Kh=K+rowbase*DM+cq,*Vh=V+rowbase*DM+cv;
  const unsigned lds0=(unsigned)(uintptr_t)shm;
  float*wsf=(float*)(shm+LDS_WS)+wid*64;
  const bf16*ksrc=Kh+(long)lane*DM+wid*8;
  const bf16*vsrc=Vh+(long)(16*(wid&3)+(lane>>2))*DM+(wid>>2)*32+(lane&3)*8;
  const unsigned kdst=lds0+LDS_K+wid*1024, vdst=lds0+LDS_V+wid*1024;
  #define DMA_K(t,slot) glds16(ksrc+(long)(t)*KVBLK*DM,(unsigned)__builtin_amdgcn_readfirstlane(kdst+(slot)))
  #define DMA_V(t,slot) glds16(vsrc+(long)(t)*KVBLK*DM,(unsigned)__builtin_amdgcn_readfirstlane(vdst+(slot)))
  const int vb0=(int)(lds0+LDS_V)+((lane>>4)&1)*32+(lane&3)*8+(4*hi+((lane&15)>>2))*64;
  const char*Kbase=shm+LDS_K; bf16x8 kf[8];
  const lds_cptr shm3=(lds_cptr)shm; const lds_cptr kp0=shm3+LDS_K+hi*1024+r32*16; const lds_cptr vp0=shm3+LDS_V+((lane>>4)&1)*32+(lane&3)*8+(4*hi+((lane&15)>>2))*64;
  const int NT=(q0+QB)/KVBLK;
  DMA_K(0,0);DMA_V(0,0);DMA_K(1,SLOTB);
  bf16x8 qr[4];
  #pragma unroll
  for(int d0=0;d0<4;++d0)qr[d0]=*reinterpret_cast<const bf16x8*>(&Qw[(long)r32*DM+d0*16+hi*8]);
  float mhat=0.f,l_reg=0.f;f32x16 o[2];o[0]=f32x16{};o[1]=f32x16{};f32x16 negm=f32x16{};asm volatile("":"+v"(negm));
  const int qrel=wid*QBLK+r32;
  #define CMASK(P0,P1,t) do{int jb_=(t)-(NT-4); if(jb_>=0)cmask(P0,P1,jb_,qrel,hi);}while(0)
  bool resc=false;
  #define START(P0,P1) do{ const float rm=rowmax(P0,P1); resc=false; \
    { const float dl=rm; mhat=fadd_s(mhat,dl); \
      _Pragma("unroll") for(int r=0;r<16;++r){P0[r]=fsub_s(P0[r],dl);P1[r]=fsub_s(P1[r],dl);} \
      _Pragma("unroll") for(int r=0;r<16;++r)negm[r]=-mhat; asm volatile("":"+v"(negm)); } \
    _Pragma("unroll") for(int r=0;r<16;++r)P0[r]=__builtin_amdgcn_exp2f(P0[r]); }while(0)
  #define RESC() do{ if(resc){ asm volatile("s_waitcnt lgkmcnt(0)":::"memory"); \
      _Pragma("unroll") for(int d_=0;d_<2;++d_) _Pragma("unroll") for(int r=0;r<16;++r)o[d_][r]*=wsf[crow(r,hi)]; } }while(0)
  f32x16 pA0,pA1,pB0,pB1;
  int sl_prev=0,sl_cur=0,sl_next=SLOTB;
  #define ROT() do{sl_prev=sl_cur;sl_cur=sl_next;sl_next=(sl_next==(NSLOT-1)*SLOTB)?0:sl_next+SLOTB;}while(0)
  DMA_K(2,2*SLOTB);
  WAIT_BAR(3);
  qkt(pA0,pA1,Kbase,qr,negm,r32,hi);asm volatile("s_nop 15\n\ts_nop 7":"+v"(pA0),"+v"(pA1));CMASK(pA0,pA1,0);
  START(pA0,pA1);
  _Pragma("unroll") for(int r=0;r<16;++r)pA1[r]=__builtin_amdgcn_exp2f(pA1[r]);
  WAIT_BAR(0);
  DMA_K(3,0);DMA_V(1,SLOTB);
  ROT();
  kload8(kf,kp0+sl_cur);
  WAIT_BAR(2);
  s16x4 vlo[8],vhi[8]; u32x4 pw0,pw1,pw2,pw3;
  #define PKW(P,B) cvtpk_s(P[B],P[B+1])
  #define PAF(k) __builtin_bit_cast(bf16x8,pw##k)
  #define VFR(i) (bf16x8){vlo[i][0],vlo[i][1],vlo[i][2],vlo[i][3],vhi[i][0],vhi[i][1],vhi[i][2],vhi[i][3]}
  #define PIN(x) asm volatile("":"+v"(x))
  #define MX3(a,b,c) __builtin_fmaxf(__builtin_fmaxf((a),(b)),(c))
  #define GAPA(MF,A0,A1,A2,A3,W0,W1,PW) do{ MF; sacc+=A0; sacc+=A1; sacc+=A2; sacc+=A3; PIN(sacc); W0; W1; PIN(PW); SBAR(); }while(0)
  #define EX(v) __builtin_amdgcn_exp2f(v)
  #define GAPB(MF,X,B) do{ MF; X[B]=EX(X[B]); X[B+1]=EX(X[B+1]); X[B+2]=EX(X[B+2]); X[B+3]=EX(X[B+3]); PIN(X); SBAR(); }while(0)
  #define VRD(i) do{ vlo[i]=vtr(vp_+(((i)>>2)*4096+((i)&3)*1024)); vhi[i]=vtr(vp_+(((i)>>2)*4096+((i)&3)*1024+512)); }while(0)
  #define KRD(G,j) do{ if(G){ kload2(kf,kp0+sl_next,j); SBAR(); } }while(0)
  #define STEP(C0,C1,P0,P1,t,GK,GV,GL) do{ SBAR(); \
    const lds_cptr vp_=vp0+sl_prev; \
    VRD(0); SBAR(); float sacc=(P0[0]+P0[1]); \
    GAPA(C0=__builtin_amdgcn_mfma_f32_32x32x16_bf16(kf[0],qr[0],negm,0,0,0), P0[2],P0[3],P0[4],P0[5],     pw0[0]=PKW(P0,0), pw0[1]=PKW(P0,2), pw0); \
    VRD(4); SBAR(); GAPA(C1=__builtin_amdgcn_mfma_f32_32x32x16_bf16(kf[1],qr[0],negm,0,0,0), P0[6],P0[7],P0[8],P0[9],     pw0[2]=PKW(P0,4), pw0[3]=PKW(P0,6), pw0); \
    VRD(1); SBAR(); GAPA(C0=__builtin_amdgcn_mfma_f32_32x32x16_bf16(kf[2],qr[1],C0,0,0,0),   P0[10],P0[11],P0[12],P0[13], pw1[0]=PKW(P0,8), pw1[1]=PKW(P0,10), pw1); \
    VRD(5); SBAR(); GAPA(C1=__builtin_amdgcn_mfma_f32_32x32x16_bf16(kf[3],qr[1],C1,0,0,0),   P0[14],P0[15],P1[0],P1[1],   pw1[2]=PKW(P0,12),pw1[3]=PKW(P0,14), pw1); \
    VRD(2); SBAR(); GAPA(C0=__builtin_amdgcn_mfma_f32_32x32x16_bf16(kf[4],qr[2],C0,0,0,0),   P1[2],P1[3],P1[4],P1[5],     pw2[0]=PKW(P1,0), pw2[1]=PKW(P1,2), pw2); \
    VRD(6); SBAR(); GAPA(C1=__builtin_amdgcn_mfma_f32_32x32x16_bf16(kf[5],qr[2],C1,0,0,0),   P1[6],P1[7],P1[8],P1[9],     pw2[2]=PKW(P1,4), pw2[3]=PKW(P1,6), pw2); \
    VRD(3); SBAR(); GAPA(C0=__builtin_amdgcn_mfma_f32_32x32x16_bf16(kf[6],qr[3],C0,0,0,0),   P1[10],P1[11],P1[12],P1[13], pw3[0]=PKW(P1,8), pw3[1]=PKW(P1,10), pw3); \
    VRD(7); SBAR(); GAPA(C1=__builtin_amdgcn_mfma_f32_32x32x16_bf16(kf[7],qr[3],C1,0,0,0),   P1[14],P1[15],0.f,0.f,       pw3[2]=PKW(P1,12),pw3[3]=PKW(P1,14), pw3); \
    l_reg+=sacc; \
    if(GK){DMA_K((t)+3,sl_cur);} if(GV){DMA_V((t)+1,sl_next);} \
    CMASK(C0,C1,t); \
    { float a=MX3(C0[0],C0[1],C1[0]),b=MX3(C0[2],C0[3],C1[1]); a=MX3(a,C1[2],C1[3]); \
      _Pragma("unroll") for(int r=4;r<16;r+=4){a=MX3(a,C0[r],C0[r+1]);b=MX3(b,C0[r+2],C0[r+3]);a=MX3(a,C1[r],C1[r+1]);b=MX3(b,C1[r+2],C1[r+3]);} \
      float rm=__builtin_fmaxf(a,b); { auto rr=__builtin_amdgcn_permlane32_swap(__float_as_uint(rm),__float_as_uint(rm),false,false); rm=__builtin_fmaxf(__uint_as_float(rr[0]),__uint_as_float(rr[1])); } \
      resc=false; \
      if(__builtin_expect(__any(rm>(float)THRL),0)){ const float dl=__builtin_fmaxf(rm,0.f); mhat+=dl; \
        _Pragma("unroll") for(int r=0;r<16;++r){C0[r]-=dl;C1[r]-=dl;} \
        _Pragma("unroll") for(int r=0;r<16;++r)negm[r]=-mhat; asm volatile("":"+v"(negm)); \
        const float f=__builtin_amdgcn_exp2f(-dl); l_reg*=f; if(hi==0)wsf[r32]=f; resc=true; } } \
    SBAR(); \
    GAPB(o[0]=__builtin_amdgcn_mfma_f32_32x32x16_bf16(PAF(0),VFR(0),o[0],0,0,0), C0,0); \
    GAPB(o[1]=__builtin_amdgcn_mfma_f32_32x32x16_bf16(PAF(0),VFR(4),o[1],0,0,0), C0,4); \
    KRD(GL,0); GAPB(o[0]=__builtin_amdgcn_mfma_f32_32x32x16_bf16(PAF(1),VFR(1),o[0],0,0,0), C0,8); \
    KRD(GL,1); GAPB(o[1]=__builtin_amdgcn_mfma_f32_32x32x16_bf16(PAF(1),VFR(5),o[1],0,0,0), C0,12); \
    KRD(GL,2); GAPB(o[0]=__builtin_amdgcn_mfma_f32_32x32x16_bf16(PAF(2),VFR(2),o[0],0,0,0), C1,0); \
    KRD(GL,3); GAPB(o[1]=__builtin_amdgcn_mfma_f32_32x32x16_bf16(PAF(2),VFR(6),o[1],0,0,0), C1,4); \
    GAPB(o[0]=__builtin_amdgcn_mfma_f32_32x32x16_bf16(PAF(3),VFR(3),o[0],0,0,0), C1,8); \
    GAPB(o[1]=__builtin_amdgcn_mfma_f32_32x32x16_bf16(PAF(3),VFR(7),o[1],0,0,0), C1,12); \
    }while(0)
  int t=1;
  #undef CMASK
  #define CMASK(P0,P1,t) do{}while(0)
  for(;t+5<NT;t+=2){
    STEP(pB0,pB1,pA0,pA1,t,true,true,true);     WAIT_BAR(2); RESC(); ROT();
    STEP(pA0,pA1,pB0,pB1,t+1,true,true,true);   WAIT_BAR(2); RESC(); ROT();
  }
  #undef CMASK
  #define CMASK(P0,P1,t) do{int jb_=(t)-(NT-4); if(jb_>=0)cmask(P0,P1,jb_,qrel,hi);}while(0)
  #define ENDW(tt) do{ if((tt)+3<NT){WAIT_BAR(2);} else if((tt)+2<NT){WAIT_BAR(1);} else {WAIT_BAR(0);} }while(0)
  for(;t+1<NT;t+=2){
    STEP(pB0,pB1,pA0,pA1,t,(t+3<NT),(t+1<NT),(t+1<NT));       ENDW(t);   RESC(); ROT();
    STEP(pA0,pA1,pB0,pB1,t+1,(t+4<NT),(t+2<NT),(t+2<NT));     ENDW(t+1); RESC(); ROT();
  }
  STEP(pB0,pB1,pA0,pA1,NT-1,false,false,false); RESC();
  { float sacc=pB0[0]+pB0[1]; _Pragma("unroll") for(int r=2;r<16;++r)sacc+=pB0[r]; _Pragma("unroll") for(int r=0;r<16;++r)sacc+=pB1[r]; l_reg+=sacc;
    pw0=(u32x4){PKW(pB0,0),PKW(pB0,2),PKW(pB0,4),PKW(pB0,6)};pw1=(u32x4){PKW(pB0,8),PKW(pB0,10),PKW(pB0,12),PKW(pB0,14)};pw2=(u32x4){PKW(pB1,0),PKW(pB1,2),PKW(pB1,4),PKW(pB1,6)};pw3=(u32x4){PKW(pB1,8),PKW(pB1,10),PKW(pB1,12),PKW(pB1,14)};
    SBAR(); pv(o,vb0+sl_cur,PAF(0),PAF(1),PAF(2),PAF(3)); }
  #undef PKW
  #undef PAF
  #undef VFR
  #undef PIN
  #undef MX3
  #undef GAPA
  #undef GAPB
  #undef EX
  #undef VRD
  #undef KRD
  #undef STEP
  #undef ENDW
  {auto rr=__builtin_amdgcn_permlane32_swap(__float_as_uint(l_reg),__float_as_uint(l_reg),false,false);l_reg=__uint_as_float(rr[0])+__uint_as_float(rr[1]);}
  if(hi==0)wsf[32+r32]=l_reg;asm volatile("s_waitcnt lgkmcnt(0)":::"memory");
  float rli[16];
  #pragma unroll
  for(int r=0;r<16;++r)rli[r]=__builtin_amdgcn_rcpf(wsf[32+crow(r,hi)]);
  bf16*Ow=O+(rowbase+q0+wid*QBLK)*DM+cv;
  { bf16*stg=(bf16*)(shm+LDS_OST)+wid*2048;
    #pragma unroll
    for(int r=0;r<16;++r){const int orow=crow(r,hi);
      #pragma unroll
      for(int d0=0;d0<2;++d0)stg[orow*64+d0*32+r32]=__float2bfloat16(o[d0][r]*rli[r]);}
    asm volatile("s_waitcnt lgkmcnt(0)":::"memory");
    #pragma unroll
    for(int i=0;i<4;++i){const int row=i*8+(lane>>3),ch=lane&7; const u32x4 v=*(const u32x4*)(stg+row*64+ch*8); ATTN_STORE16(Ow+(long)row*DM+ch*8,v);} }
  asm volatile("s_waitcnt lgkmcnt(0)\n\ts_barrier":::"memory");
  #undef DMA_K
  #undef DMA_V
  #undef CMASK
  #undef START
  #undef RESC
  #undef ROT
}
constexpr int ATTN_LDS_BYTES=LDS_BYTES;
#undef SBAR
#undef WAIT_BAR
}
#define LAS __attribute__((address_space(3)))
using pg8::bf16_t; using pg8::f32x4; using pg8::u32x4; using pg8::bf16x8; using pg8::cvt_pk_bf16; using pg8::f32x2;
typedef unsigned u32x2 __attribute__((ext_vector_type(2)));
constexpr int NB = 8, S = 4096, D = 1024, T = NB * S, FF = 2816, FF2 = 5632, SP = S + 8;
constexpr int NWAVES = 8, NTHR = 512;
constexpr size_t MiB = 1u << 20;
constexpr size_t WS_W = 0, WS_H = 112 * MiB, WS_A = 177 * MiB;
constexpr size_t WS_VF = WS_A, WS_L = WS_A + 64 * MiB, WS_R = WS_A + 96 * MiB, WS_K = WS_A + 160 * MiB, WS_V1 = WS_A + 224 * MiB;
constexpr size_t WS_ACT_R = WS_R;
constexpr size_t WS_KS = WS_A, WS_VS = WS_A + 64 * MiB, WS_Q = WS_A + 128 * MiB, WS_O0 = WS_A + 192 * MiB, WS_O1 = WS_A + 256 * MiB;
constexpr size_t WS_HK = WS_O0, WS_ACT_B = WS_Q;
constexpr size_t WS_MOD = 497 * MiB, WS_ROPE = 498 * MiB, WS_CTL = 499 * MiB, WS_END = 500 * MiB, WS_MODP = WS_R;
constexpr size_t WS_SS = WS_CTL + 131072;
constexpr size_t WS_BIASUP = WS_ROPE + 262144;
constexpr size_t WS_BIASQ = WS_MOD + 786432;
constexpr size_t WS_KVNC = WS_BIASQ + 65536;
static_assert((size_t)(NB * SP + 128) * D * 2 <= 65 * MiB, "H");
static_assert((size_t)T * FF * 2 <= 176 * MiB, "act");
constexpr size_t NRKVL = 3584;
constexpr size_t WE_RWKV = NRKVL * 2048 + (size_t)D * D + (size_t)D * 320;
constexpr size_t WE_FFN = (size_t)FF2 * D + (size_t)D * FF;
__host__ __device__ constexpr size_t we_rkvl(int l) { return (size_t)l * WE_RWKV; }
__host__ __device__ constexpr size_t we_woa(int l) { return we_rkvl(l) + NRKVL * 2048; }
__host__ __device__ constexpr size_t we_lb(int l) { return we_woa(l) + (size_t)D * D; }
__host__ __device__ constexpr size_t we_up(int l) { return 2 * WE_RWKV + (size_t)l * WE_FFN; }
__host__ __device__ constexpr size_t we_dn(int l) { return we_up(l) + (size_t)FF2 * D; }
constexpr size_t WE_KV = 2 * WE_RWKV + 4 * WE_FFN;
__host__ __device__ constexpr size_t we_q(int j) { return WE_KV + (size_t)2 * D * D + (size_t)j * D * D; }
__host__ __device__ constexpr size_t we_ob(int j) { return WE_KV + (size_t)4 * D * D + (size_t)j * D * D; }
static_assert((WE_KV + (size_t)6 * D * D) * 2 <= 112 * MiB, "weights");
constexpr int LDS_BYTES = 147456;

__device__ __forceinline__ float bf2f(unsigned short h) { return __uint_as_float((unsigned)h << 16); }

template <int CTRL> __device__ __forceinline__ float dppf(float v) { return __int_as_float(__builtin_amdgcn_update_dpp(0, __float_as_int(v), CTRL, 0xf, 0xf, true)); }
__device__ __forceinline__ float sigm(float x) { return __builtin_amdgcn_rcpf(1.f + __expf(-x)); }
__device__ __forceinline__ float row16_sum(float v) { v += dppf<0xB1>(v); v += dppf<0x4E>(v); v += dppf<0x141>(v); v += dppf<0x140>(v); return v; }
__device__ __forceinline__ float row8_sum(float v) { v += dppf<0xB1>(v); v += dppf<0x4E>(v); v += dppf<0x141>(v); return v; }
__device__ __forceinline__ float xlane16(float v) { return v + __int_as_float(__builtin_amdgcn_ds_swizzle(__float_as_int(v), 0x401F)); }
__device__ __forceinline__ float xlane32(float v) { auto rr = __builtin_amdgcn_permlane32_swap(__float_as_uint(v), __float_as_uint(v), false, false); return __uint_as_float(rr[0]) + __uint_as_float(rr[1]); }
__device__ __forceinline__ float wave_sum_dpp(float v) {
    v = row16_sum(v);
    return __int_as_float(__builtin_amdgcn_readlane(__float_as_int(v), 0)) + __int_as_float(__builtin_amdgcn_readlane(__float_as_int(v), 16)) +
           __int_as_float(__builtin_amdgcn_readlane(__float_as_int(v), 32)) + __int_as_float(__builtin_amdgcn_readlane(__float_as_int(v), 48));
}
__device__ __forceinline__ float wave_sum(float v) { return wave_sum_dpp(v); }
#define BAR_LDS() asm volatile("s_waitcnt lgkmcnt(0)\n\ts_barrier" ::: "memory")

#define GAS __attribute__((address_space(1)))
#define GLD4(p, boff) (*(const GAS f32x4*)((const GAS char*)(p) + (unsigned)(boff)))
struct EpiRkvL {
    static constexpr bool PERM = true, AFTER_DRAIN = false;
    bf16_t *R, *K, *V, *L;
    __device__ __forceinline__ void operator()(const f32x4 (&acc)[2][2][4][2], const pg8::Unit& u, int wr, int wc, int fr, int fq) const {
        { int t_ = threadIdx.x; asm volatile("" : "+v"(t_)); fr = t_ & 15; fq = (t_ >> 4) & 3; }
        const int pn = u.pn; const int ldc = pn < 12 ? D : 512, colt = pn < 12 ? (pn & 3) * 256 : (pn - 12) * 256;
        unsigned long long bp = (unsigned long long)(uintptr_t)L;
        if (pn < 12) bp = (unsigned long long)(uintptr_t)V;
        asm volatile("" : "+s"(bp));
        if (pn < 8) bp = (unsigned long long)(uintptr_t)K;
        asm volatile("" : "+s"(bp));
        if (pn < 4) bp = (unsigned long long)(uintptr_t)R;
        GAS char* base = (GAS char*)(uintptr_t)bp;
        const int row0 = u.pm * 256 + wr * 64 + fr, col0 = colt + wc * 32 + 8 * fq;
#pragma unroll
        for (int ai = 0; ai < 2; ++ai)
#pragma unroll
            for (int m = 0; m < 4; ++m) { const unsigned off = ((unsigned)(row0 + ai * 128 + m * 16) * (unsigned)ldc + (unsigned)col0) * 2u;
#pragma unroll
                for (int bj = 0; bj < 2; ++bj) { f32x4 v0 = acc[ai][bj][m][0], v1 = acc[ai][bj][m][1];
                    if (pn >= 12) {
                        const int c0 = col0 + bj * 128;
                        const int ty = c0 < 64 ? 1 : ((c0 >= 160 && c0 < 320) ? 2 : 0);
                        if (ty) { const float A = ty == 1 ? 2.f : 1.f, C = ty == 1 ? -1.f : 0.f;
#pragma unroll
                            for (int e = 0; e < 4; ++e) { v0[e] = A * sigm(A * v0[e]) + C; v1[e] = A * sigm(A * v1[e]) + C; } } }
                    u32x4 w; w.x = cvt_pk_bf16(v0[0], v0[1]); w.y = cvt_pk_bf16(v0[2], v0[3]); w.z = cvt_pk_bf16(v1[0], v1[1]); w.w = cvt_pk_bf16(v1[2], v1[3]);
                    *(GAS u32x4*)(base + off + bj * 256) = w; } }
    }
};
struct EpiRes {
    static constexpr bool PERM = false, AFTER_DRAIN = false;
    const float* base; float* out; unsigned char* wsb; const float* nwn; unsigned gate_off, sc_off, ss_off; int next;
    __device__ __forceinline__ void operator()(const f32x4 (&acc)[2][2][4][2], const pg8::Unit& u, int wr, int wc, int fr, int fq) const {
        { int t_ = threadIdx.x; asm volatile("" : "+v"(t_)); fr = t_ & 15; fq = (t_ >> 4) & 3; }
        const int b = u.pm >> 4, col0 = u.pn * 256 + wc * 32 + 4 * fq;
        f32x4 gv[2][2], gm[2][2];
#pragma unroll
        for (int bj = 0; bj < 2; ++bj)
#pragma unroll
            for (int n = 0; n < 2; ++n) { gv[bj][n] = GLD4(wsb, gate_off + (b * 6144 + col0 + bj * 128 + n * 16) * 4);
                gm[bj][n] = next ? GLD4(nwn, (col0 + bj * 128 + n * 16) * 4) * (GLD4(wsb, sc_off + (b * 6144 + col0 + bj * 128 + n * 16) * 4) + 1.f) : gv[bj][n]; }
#pragma unroll
        for (int ai = 0; ai < 2; ++ai) {
            f32x4 bsa[4][2][2];
#pragma unroll
            for (int m = 0; m < 4; ++m) { const unsigned off = ((unsigned)(u.pm * 256 + ai * 128 + wr * 64 + m * 16 + fr) * (unsigned)D + (unsigned)col0) * 4u;
#pragma unroll
                for (int bj = 0; bj < 2; ++bj)
#pragma unroll
                    for (int n = 0; n < 2; ++n) bsa[m][bj][n] = GLD4(base, off + bj * 512 + n * 64); }
#pragma unroll
            for (int m = 0; m < 4; ++m) { const int row = u.pm * 256 + ai * 128 + wr * 64 + m * 16 + fr; const unsigned off = ((unsigned)row * (unsigned)D + (unsigned)col0) * 4u;
                f32x4 bs[2][2];
#pragma unroll
                for (int bj = 0; bj < 2; ++bj)
#pragma unroll
                    for (int n = 0; n < 2; ++n) { bs[bj][n] = bsa[m][bj][n] + gv[bj][n] * acc[ai][bj][m][n]; *(GAS f32x4*)((GAS char*)out + (off + bj * 512 + n * 64)) = bs[bj][n]; }
                if (next) { float sq = 0.f; const unsigned hoff = (unsigned)WS_H + ((unsigned)(b * SP + 8 + (row & (S - 1))) * (unsigned)D + (unsigned)col0) * 2u;
#pragma unroll
                    for (int bj = 0; bj < 2; ++bj)
#pragma unroll
                        for (int n = 0; n < 2; ++n) { const f32x4 x = bs[bj][n]; sq += (x[0] * x[0] + x[1] * x[1]) + (x[2] * x[2] + x[3] * x[3]); const f32x4 h = x * gm[bj][n];
                            u32x2 w; w.x = cvt_pk_bf16(h[0], h[1]); w.y = cvt_pk_bf16(h[2], h[3]); *(GAS u32x2*)((GAS char*)wsb + (hoff + bj * 256 + n * 32)) = w;
                            if (next == 2) { const f32x4 k = x * GLD4(wsb, (unsigned)WS_KVNC + (col0 + bj * 128 + n * 16) * 4); u32x2 w2; w2.x = cvt_pk_bf16(k[0], k[1]); w2.y = cvt_pk_bf16(k[2], k[3]);
                                *(GAS u32x2*)((GAS char*)wsb + ((unsigned)(WS_HK - WS_H) + hoff + bj * 256 + n * 32)) = w2; } }
                    sq = xlane32(xlane16(sq));
                    if (fq == 0) (void)__builtin_amdgcn_global_atomic_fadd_f32((GAS float*)((GAS char*)wsb + ss_off) + row, sq); }
            }
        }
    }
};
struct EpiRope {
    static constexpr bool PERM = false, AFTER_DRAIN = false;
    unsigned char* wsb; unsigned oa_off, ob_off, ss_off, bias_off; float scale0; int defer, hasbias;
    __device__ __forceinline__ void operator()(const f32x4 (&acc)[2][2][4][2], const pg8::Unit& u, int wr, int wc, int fr, int fq) const {
        { int t_ = threadIdx.x; asm volatile("" : "+v"(t_)); fr = t_ & 15; fq = (t_ >> 4) & 3; }
        const bool ra = u.pn < 4; GAS char* O = (GAS char*)wsb + (ra ? oa_off : ob_off); const float sc = ra ? scale0 : 1.f;
        const int col0 = (u.pn & 3) * 256 + wc * 32 + 4 * fq; const bool dorope = ra && ((wc & 1) == 0) && fq < 2;
#pragma unroll
        for (int ai = 0; ai < 2; ++ai)
#pragma unroll
            for (int m = 0; m < 4; ++m) { const int row = u.pm * 256 + ai * 128 + wr * 64 + m * 16 + fr; const int t = row & (S - 1);
                const float rs = defer ? rsqrtf(*(const GAS float*)((const GAS char*)wsb + (ss_off + (unsigned)row * 4u)) * (1.f / D) + 1e-6f) : 1.f;
                f32x4 cs = {1.f, 1.f, 1.f, 1.f}, sn = {0.f, 0.f, 0.f, 0.f};
                if (dorope) { cs = GLD4(wsb, (unsigned)WS_ROPE + (t * 8 + 4 * fq) * 4); sn = GLD4(wsb, (unsigned)WS_ROPE + (S * 8 + t * 8 + 4 * fq) * 4); }
#pragma unroll
                for (int bj = 0; bj < 2; ++bj) { f32x4 x1 = acc[ai][bj][m][0] * rs, x2 = acc[ai][bj][m][1] * rs;
                    if (hasbias) { const unsigned bo = bias_off + (unsigned)((u.pm >> 4) * D + col0 + bj * 128) * 4u; x1 = x1 + GLD4(wsb, bo); x2 = x2 + GLD4(wsb, bo + 64); }
                    const f32x4 o1 = (x1 * cs - x2 * sn) * sc, o2 = (x2 * cs + x1 * sn) * sc;
                    u32x2 w1, w2; w1.x = cvt_pk_bf16(o1[0], o1[1]); w1.y = cvt_pk_bf16(o1[2], o1[3]); w2.x = cvt_pk_bf16(o2[0], o2[1]); w2.y = cvt_pk_bf16(o2[2], o2[3]);
                    const unsigned off = ((unsigned)row * (unsigned)D + (unsigned)(col0 + bj * 128)) * 2u; *(GAS u32x2*)(O + off) = w1; *(GAS u32x2*)(O + off + 32) = w2; } }
    }
};
struct EpiUp {
    static constexpr bool PERM = false, AFTER_DRAIN = false;
    unsigned char* wsb; const float* cw; const float* cb; unsigned act_off, ss_off, bias_off;
    __device__ __forceinline__ void operator()(const f32x4 (&acc)[2][2][4][2], const pg8::Unit& u, int wr, int wc, int fr, int fq) const {
        { int t_ = threadIdx.x; asm volatile("" : "+v"(t_)); fr = t_ & 15; fq = (t_ >> 4) & 3; }
        const int b = u.pm / 17, ui = u.pm % 17;
#pragma unroll
        for (int n = 0; n < 2; ++n) { const int ch0 = 128 * u.pn + 32 * wc + 16 * n + 4 * fq;
            const unsigned bo_ = bias_off + (unsigned)(b * FF2 + 256 * u.pn + 32 * wc + 16 * n + 4 * fq) * 4u;
#pragma unroll
            for (int ai = 0; ai < 2; ++ai) { const int tb = 248 * ui + 62 * (2 * ai + wr) - 2;
                float rs[4];
#pragma unroll
                for (int m = 0; m < 4; ++m) { const int t = tb + 16 * m + fr; const bool in = t >= 0 && t < S;
                    rs[m] = in ? rsqrtf(*(const GAS float*)((const GAS char*)wsb + (ss_off + (unsigned)(b * S + (in ? t : 0)) * 4u)) * (1.f / D) + 1e-6f) : 0.f; }
                const bool z0 = (tb + fr) < 0;
                f32x4 ug[4];
                { const f32x4 w0 = GLD4(cw, ch0 * 4), w1 = GLD4(cw, (FF2 + ch0) * 4), w2 = GLD4(cw, (2 * FF2 + ch0) * 4), bb = GLD4(cb, ch0 * 4), bu0 = GLD4(wsb, bo_);
                    f32x4 q1 = bb, q2 = bb;
#pragma unroll
                    for (int m = 0; m < 4; ++m) { f32x4 x = acc[ai][0][m][n] * rs[m] + bu0; if (m == 0 && z0) x = (f32x4){0.f, 0.f, 0.f, 0.f}; f32x4 r1, r2;
#pragma unroll
                        for (int j = 0; j < 4; ++j) { r1[j] = dppf<0x121>(x[j]); r2[j] = dppf<0x122>(x[j]); }
                        const f32x4 p1 = fr == 0 ? q1 : r1, p2 = fr < 2 ? q2 : r2; ug[m] = bb + w0 * p2 + w1 * p1 + w2 * x; q1 = r1; q2 = r2; } }
                { const int c = ch0 + FF; const f32x4 w0 = GLD4(cw, c * 4), w1 = GLD4(cw, (FF2 + c) * 4), w2 = GLD4(cw, (2 * FF2 + c) * 4), bb = GLD4(cb, c * 4), bu1 = GLD4(wsb, bo_ + 512);
                    f32x4 q1 = bb, q2 = bb;
#pragma unroll
                    for (int m = 0; m < 4; ++m) { f32x4 x = acc[ai][1][m][n] * rs[m] + bu1; if (m == 0 && z0) x = (f32x4){0.f, 0.f, 0.f, 0.f}; f32x4 r1, r2;
#pragma unroll
                        for (int j = 0; j < 4; ++j) { r1[j] = dppf<0x121>(x[j]); r2[j] = dppf<0x122>(x[j]); }
                        const f32x4 p1 = fr == 0 ? q1 : r1, p2 = fr < 2 ? q2 : r2; const f32x4 uv = bb + w0 * p2 + w1 * p1 + w2 * x; q1 = r1; q2 = r2;
                        const int rr = 16 * m + fr, t = tb + rr; const f32x4 g = ug[m]; f32x4 o;
#pragma unroll
                        for (int j = 0; j < 4; ++j) o[j] = g[j] * sigm(g[j]) * uv[j];
                        if (rr >= 2 && t < S) { u32x2 w; w.x = cvt_pk_bf16(o[0], o[1]); w.y = cvt_pk_bf16(o[2], o[3]); *(GAS u32x2*)((GAS char*)wsb + (act_off + ((unsigned)(b * S + t) * (unsigned)FF + (unsigned)ch0) * 2u)) = w; } } }
                __builtin_amdgcn_sched_barrier(0);
            } }
    }
};

struct Job { const float* W; const float* mu; bf16_t* Bt; int ldw, K, N, ldb, kdst0, mode, map, rowoff, start; };
__device__ __forceinline__ int colmap(int map, int n) {
    if (map == 1) { const int half = n >= FF ? 1 : 0, ch = n - half * FF; return 256 * (ch >> 7) + 128 * half + (ch & 127); }
    if (map == 2) { const int d = n & 63; const int p = (d >= 8 && d < 16) ? d + 8 : ((d >= 16 && d < 24) ? d - 8 : d); return (n & ~63) + p; }
    return n;
}
__device__ __forceinline__ void tr_load(const LAS Job* jb, int item, float (&v)[32], int lane) {
    const float* W = jb->W; const float* mu = jb->mu; const int ldw = jb->ldw, N = jb->N, mode = jb->mode;
    const int nblk = N / 32, kb = item / nblk, nb = item % nblk, k0 = 64 * kb, n0 = 32 * nb;
#pragma unroll
    for (int i = 0; i < 32; ++i) { const int kk = 2 * i + (lane >> 5); float x = W[(size_t)(k0 + kk) * ldw + n0 + (lane & 31)];
        if (mode) { const float m = mu[k0 + kk]; x *= (mode == 1) ? (1.f - m) : m; }
        v[i] = x; }
}
__device__ __forceinline__ void tr_store(const LAS Job* jb, int item, const float (&v)[32], LAS float* scr, int lane) {
    bf16_t* Bt = jb->Bt; const int N = jb->N, ldb = jb->ldb, kdst0 = jb->kdst0, map = jb->map, rowoff = jb->rowoff;
    const int nblk = N / 32, kb = item / nblk, nb = item % nblk, k0 = 64 * kb, n0 = 32 * nb;
#pragma unroll
    for (int i = 0; i < 32; ++i) scr[(2 * i + (lane >> 5)) * 33 + (lane & 31)] = v[i];
    asm volatile("s_waitcnt lgkmcnt(0)" ::: "memory");
    const int c = lane & 7;
#pragma unroll
    for (int j = 0; j < 4; ++j) { const int n = (lane >> 3) + 8 * j; const LAS float* s = scr + (8 * c) * 33 + n;
        u32x4 o; o.x = cvt_pk_bf16(s[0 * 33], s[1 * 33]); o.y = cvt_pk_bf16(s[2 * 33], s[3 * 33]); o.z = cvt_pk_bf16(s[4 * 33], s[5 * 33]); o.w = cvt_pk_bf16(s[6 * 33], s[7 * 33]);
        *(u32x4*)(Bt + (size_t)(rowoff + colmap(map, n0 + n)) * ldb + kdst0 + k0 + 8 * c) = o; }
    asm volatile("s_waitcnt lgkmcnt(0)" ::: "memory");
}
__device__ __forceinline__ float rope_inv(int i) {
    return i == 0 ? 1.0f : i == 1 ? 0.1939227432012558f : i == 2 ? 0.03760603070259094f : i == 3 ? 0.007292664609849453f : i == 4 ? 0.0014142135623842478f
         : i == 5 ? 0.00027424818836152554f : i == 6 ? 5.3182957344688475e-05f : 1.0313385246263351e-05f;
}

__device__ __forceinline__ void norm_phase(const float* x, const float* nw, const float* modl, int shoff, int scoff, bf16_t* H, const float* kvn, bf16_t* HK, int gw, int NGW, int lane) {
    for (int row = gw; row < T; row += NGW) {
        const int b = row >> 12, t = row & (S - 1);
        const f32x4* xr = (const f32x4*)(x + (size_t)row * D) + lane;
        f32x4 v[4]; float ss = 0.f;
#pragma unroll
        for (int j = 0; j < 4; ++j) { v[j] = xr[64 * j]; ss += (v[j].x * v[j].x + v[j].y * v[j].y) + (v[j].z * v[j].z + v[j].w * v[j].w); }
        const float rstd = rsqrtf(wave_sum(ss) * (1.f / D) + 1e-6f);
        const float* mb = modl + (size_t)b * 6144;
        const size_t orow = ((size_t)b * SP + 8 + t) * D;
#pragma unroll
        for (int j = 0; j < 4; ++j) { const int col = 4 * (lane + 64 * j);
            const f32x4 g = *(const f32x4*)(nw + col), sc = *(const f32x4*)(mb + scoff + col), sh = *(const f32x4*)(mb + shoff + col);
            const f32x4 y = v[j] * rstd * g; const f32x4 h = y * (sc + 1.f) + sh;
            u32x2 w; w.x = cvt_pk_bf16(h[0], h[1]); w.y = cvt_pk_bf16(h[2], h[3]); *(u32x2*)(H + orow + col) = w;
            if (HK) { const f32x4 k = v[j] * rstd * *(const f32x4*)(kvn + col); u32x2 w2; w2.x = cvt_pk_bf16(k[0], k[1]); w2.y = cvt_pk_bf16(k[2], k[3]); *(u32x2*)(HK + orow + col) = w2; } }
    }
}
__device__ __forceinline__ void final_norm_phase(float* x, const float* nw, int gw, int NGW, int lane) {
    for (int row = gw; row < T; row += NGW) {
        f32x4* xr = (f32x4*)(x + (size_t)row * D) + lane;
        f32x4 v[4]; float ss = 0.f;
#pragma unroll
        for (int j = 0; j < 4; ++j) { v[j] = xr[64 * j]; ss += (v[j].x * v[j].x + v[j].y * v[j].y) + (v[j].z * v[j].z + v[j].w * v[j].w); }
        const float rstd = rsqrtf(wave_sum(ss) * (1.f / D) + 1e-6f);
#pragma unroll
        for (int j = 0; j < 4; ++j) xr[64 * j] = v[j] * rstd * *(const f32x4*)(nw + 4 * (lane + 64 * j));
    }
}
__device__ __forceinline__ void combine_phase(bf16_t* O0, const bf16_t* O1, const float* lamv, const float* subln, float lam_init, int gw, int NGW, int lane) {
    const float d01 = wave_sum(lamv[lane] * lamv[64 + lane]), d23 = wave_sum(lamv[128 + lane] * lamv[192 + lane]);
    const float lam = __expf(d01) - __expf(d23) + lam_init, osc = 1.f - lam_init;
    float sw[16];
#pragma unroll
    for (int i = 0; i < 16; ++i) sw[i] = subln[(16 * lane + i) & 127] * osc;
    for (int row = gw; row < T; row += NGW) {
        bf16_t* p0 = O0 + (size_t)row * D + 16 * lane; const bf16_t* p1 = O1 + (size_t)row * D + 16 * lane;
        const u32x4 a0 = *(const u32x4*)p0, a1 = *(const u32x4*)(p0 + 8), b0 = *(const u32x4*)p1, b1 = *(const u32x4*)(p1 + 8);
        float o[16]; float ss = 0.f;
#pragma unroll
        for (int i = 0; i < 4; ++i) { const unsigned ua = a0[i], ub = b0[i], uc = a1[i], ud = b1[i];
            o[2 * i] = __uint_as_float(ua << 16) - lam * __uint_as_float(ub << 16); o[2 * i + 1] = __uint_as_float(ua & 0xffff0000u) - lam * __uint_as_float(ub & 0xffff0000u);
            o[8 + 2 * i] = __uint_as_float(uc << 16) - lam * __uint_as_float(ud << 16); o[8 + 2 * i + 1] = __uint_as_float(uc & 0xffff0000u) - lam * __uint_as_float(ud & 0xffff0000u); }
#pragma unroll
        for (int i = 0; i < 16; ++i) ss += o[i] * o[i];
        ss = row8_sum(ss);
        const float rstd = rsqrtf(ss * (1.f / 128.f) + 1e-6f);
        u32x4 w0, w1;
#pragma unroll
        for (int i = 0; i < 4; ++i) { w0[i] = cvt_pk_bf16(o[2 * i] * rstd * sw[2 * i], o[2 * i + 1] * rstd * sw[2 * i + 1]); w1[i] = cvt_pk_bf16(o[8 + 2 * i] * rstd * sw[8 + 2 * i], o[9 + 2 * i] * rstd * sw[9 + 2 * i]); }
        *(u32x4*)p0 = w0; *(u32x4*)(p0 + 8) = w1;
    }
}
struct ScanP { const bf16_t *R, *K, *V, *VF, *L; bf16_t* Y; const bf16_t* LB; const float *w0, *a0, *v0, *kk, *ka, *rk, *lnw, *lnb; int vres; };
__device__ __forceinline__ unsigned f2bf1(float f) { const unsigned u = __float_as_uint(f); return (u + 0x7fffu + ((u >> 16) & 1u)) >> 16; }
typedef __bf16 bf16x2c_t __attribute__((ext_vector_type(2)));
__device__ __forceinline__ unsigned cvtpk_c(float lo, float hi) { f32x2 v = {lo, hi}; bf16x2c_t b = __builtin_convertvector(v, bf16x2c_t); return __builtin_bit_cast(unsigned, b); }
template <int ACT> __device__ __forceinline__ bf16x8 act_frag(bf16x8 a) {
    float f[8];
#pragma unroll
    for (int e = 0; e < 8; ++e) { const float x = bf2f((unsigned short)a[e]); f[e] = ACT == 1 ? (2.f * sigm(2.f * x) - 1.f) : sigm(x); }
    u32x4 w; w.x = cvtpk_c(f[0], f[1]); w.y = cvtpk_c(f[2], f[3]); w.z = cvtpk_c(f[4], f[5]); w.w = cvtpk_c(f[6], f[7]);
    return __builtin_bit_cast(bf16x8, w);
}
__device__ __forceinline__ float hsum4(f32x4 v) { return (v.x + v.y) + (v.z + v.w); }
__device__ __forceinline__ void scan_phase(LAS unsigned char* lds, const ScanP& P, int G) {
    int tid_o_ = threadIdx.x; asm volatile("" : "+v"(tid_o_)); const int tid = tid_o_, lane = tid & 63, wave = __builtin_amdgcn_readfirstlane(tid >> 6);
    LAS float* ring = (LAS float*)lds;
    LAS float* ybuf = (LAS float*)(lds + 86016);
    constexpr int RB = 16 * 7 * 64;
    for (int item = blockIdx.x; item < NB * 16; item += G) {
        const int b = item >> 4, hd = item & 15; const size_t row0 = (size_t)b * S;
        if (wave < 4) {
            const int q = wave, p = lane & 7, rp = lane >> 3;
            f32x4 s0a = {0.f, 0.f, 0.f, 0.f}, s0b = s0a, s1a = s0a, s1b = s0a;
            BAR_LDS();
            int cb = 0;
            for (int c = 0; c < S / 16; ++c) {
                const LAS float* rb = ring + cb * RB; LAS float* yb = ybuf + (c & 1) * 1024;
#define CLOAD(W_, A_, B_, K_, R_, V_, tt) do { const LAS float* bs_ = rb + (tt) * 448 + 8 * p; \
                    W_[0] = *(const LAS f32x4*)(bs_); W_[1] = *(const LAS f32x4*)(bs_ + 4); A_[0] = *(const LAS f32x4*)(bs_ + 64); A_[1] = *(const LAS f32x4*)(bs_ + 68); \
                    B_[0] = *(const LAS f32x4*)(bs_ + 128); B_[1] = *(const LAS f32x4*)(bs_ + 132); K_[0] = *(const LAS f32x4*)(bs_ + 192); K_[1] = *(const LAS f32x4*)(bs_ + 196); \
                    R_[0] = *(const LAS f32x4*)(bs_ + 256); R_[1] = *(const LAS f32x4*)(bs_ + 260); V_ = *(const LAS f32x2*)(rb + (tt) * 448 + 320 + 16 * q + 2 * rp); } while (0)
                f32x4 cw[2], ca[2], cbv[2], ck[2], cr[2]; f32x2 cv;
                CLOAD(cw, ca, cbv, ck, cr, cv, 0);
#pragma unroll
                for (int t = 0; t < 16; ++t) {
                    f32x4 nw[2], na[2], nbv[2], nk[2], nr[2]; f32x2 nv;
                    if (t < 15) CLOAD(nw, na, nbv, nk, nr, nv, t + 1);
                    float sa0 = hsum4(s0a * ca[0] + s0b * ca[1]), sa1 = hsum4(s1a * ca[0] + s1b * ca[1]);
                    sa0 = row8_sum(sa0); sa1 = row8_sum(sa1);
                    s0a = s0a * cw[0] + (cbv[0] * sa0 + ck[0] * cv.x); s0b = s0b * cw[1] + (cbv[1] * sa0 + ck[1] * cv.x);
                    s1a = s1a * cw[0] + (cbv[0] * sa1 + ck[0] * cv.y); s1b = s1b * cw[1] + (cbv[1] * sa1 + ck[1] * cv.y);
                    float y0 = hsum4(s0a * cr[0] + s0b * cr[1]), y1 = hsum4(s1a * cr[0] + s1b * cr[1]);
                    y0 = row8_sum(y0); y1 = row8_sum(y1);
                    if (p < 2) yb[t * 64 + 16 * q + 2 * rp + p] = p ? y1 : y0;
                    if (t < 15) {
#pragma unroll
                        for (int e = 0; e < 2; ++e) { cw[e] = nw[e]; ca[e] = na[e]; cbv[e] = nbv[e]; ck[e] = nk[e]; cr[e] = nr[e]; }
                        cv = nv; }
                }
#undef CLOAD
                BAR_LDS();
                cb = cb == 2 ? 0 : cb + 1;
            }
        } else {
            const int j = wave - 4, fr = lane & 15, fq = lane >> 4;
            const int gch = hd * 64 + 16 * j + fr;
            const float w0c = P.w0[gch], a0c = P.a0[gch], v0c = P.vres ? P.v0[gch] : 0.f, kkc = P.kk[gch], kac = P.ka[gch];
            const f32x4 kk4 = *(const f32x4*)(P.kk + hd * 64 + 4 * fr);
            const f32x4 lnw4 = *(const f32x4*)(P.lnw + hd * 64 + 4 * fr), lnb4 = *(const f32x4*)(P.lnb + hd * 64 + 4 * fr), rk4 = *(const f32x4*)(P.rk + hd * 64 + 4 * fr);
            bf16x8 bfr[10];
#pragma unroll
            for (int i = 0; i < 10; ++i) bfr[i] = *(const bf16x8*)(P.LB + (size_t)gch * 320 + 32 * i + 8 * fq);
            bf16x8 afr[10]; unsigned short rr[4], kr[4], vr[4], vfr[4]; u32x2 k4[4];
#define SC_LOAD(cc) do { const size_t r0_ = row0 + 16 * (size_t)(cc); const bf16_t* lp_ = P.L + (r0_ + fr) * 512 + 8 * fq; \
                _Pragma("unroll") for (int i = 0; i < 10; ++i) afr[i] = *(const bf16x8*)(lp_ + 32 * i); \
                _Pragma("unroll") for (int i = 0; i < 4; ++i) { const size_t rw_ = (r0_ + 4 * fq + i) * D; rr[i] = P.R[rw_ + gch]; kr[i] = P.K[rw_ + gch]; vr[i] = P.V[rw_ + gch]; \
                    vfr[i] = P.vres ? P.VF[rw_ + gch] : (unsigned short)0; k4[i] = *(const u32x2*)(P.K + rw_ + hd * 64 + 4 * fr); } } while (0)
#define SC_PROC(nb) do { const f32x4 z_ = {0.f, 0.f, 0.f, 0.f}; \
                f32x4 wl = __builtin_amdgcn_mfma_f32_16x16x32_bf16(afr[0], bfr[0], z_, 0, 0, 0); wl = __builtin_amdgcn_mfma_f32_16x16x32_bf16(afr[1], bfr[1], wl, 0, 0, 0); \
                f32x4 al = __builtin_amdgcn_mfma_f32_16x16x32_bf16(afr[2], bfr[2], z_, 0, 0, 0); al = __builtin_amdgcn_mfma_f32_16x16x32_bf16(afr[3], bfr[3], al, 0, 0, 0); \
                f32x4 vl = __builtin_amdgcn_mfma_f32_16x16x32_bf16(afr[4], bfr[4], z_, 0, 0, 0); \
                f32x4 gl = __builtin_amdgcn_mfma_f32_16x16x32_bf16(afr[5], bfr[5], z_, 0, 0, 0); \
                _Pragma("unroll") for (int i = 6; i < 10; ++i) gl = __builtin_amdgcn_mfma_f32_16x16x32_bf16(afr[i], bfr[i], gl, 0, 0, 0); \
                _Pragma("unroll") for (int i = 0; i < 4; ++i) { \
                    const float e0 = __uint_as_float(k4[i].x << 16) * kk4.x, e1 = __uint_as_float(k4[i].x & 0xffff0000u) * kk4.y, e2 = __uint_as_float(k4[i].y << 16) * kk4.z, e3 = __uint_as_float(k4[i].y & 0xffff0000u) * kk4.w; \
                    const float ss = row16_sum((e0 * e0 + e1 * e1) + (e2 * e2 + e3 * e3)); const float rn = __builtin_amdgcn_rsqf(fmaxf(ss, 1e-24f));     \
                    const float r = bf2f(rr[i]), k = bf2f(kr[i]); float v = bf2f(vr[i]); \
                    const float dec = __expf(-0.6065306597126334f * sigm(w0c + wl[i])); const float a = sigm(a0c + al[i]); \
                    if (P.vres) { const float vg = sigm(v0c + vl[i]); v = v + (bf2f(vfr[i]) - v) * vg; } \
                    const float kkn = k * kkc * rn, kp = k * (1.f + (a - 1.f) * kac); \
                    LAS float* o_ = ring + ((nb) * 16 + 4 * fq + i) * 448 + 16 * j + fr; \
                    o_[0] = dec; o_[64] = -kkn; o_[128] = kkn * a; o_[192] = kp; o_[256] = r; o_[320] = v; o_[384] = gl[i]; } } while (0)
#define SC_POST(pc, pb) do { const int tk = 4 * j + fq; const LAS float* bs = ring + ((pb) * 16 + tk) * 448 + 4 * fr; \
                const f32x4 y = *(const LAS f32x4*)(ybuf + ((pc) & 1) * 1024 + tk * 64 + 4 * fr), kp = *(const LAS f32x4*)(bs + 192), r = *(const LAS f32x4*)(bs + 256), v = *(const LAS f32x4*)(bs + 320), g = *(const LAS f32x4*)(bs + 384); \
                const float s1 = row16_sum(hsum4(y)), s2 = row16_sum(hsum4(y * y)), s3 = row16_sum(hsum4(r * kp * rk4)); \
                const float mean = s1 * (1.f / 64.f), var = fmaxf(s2 * (1.f / 64.f) - mean * mean, 0.f), rstd = rsqrtf(var + 64e-5f); \
                const f32x4 o = ((y - mean) * rstd * lnw4 + lnb4 + v * s3) * g; \
                u32x2 w_; w_.x = cvt_pk_bf16(o[0], o[1]); w_.y = cvt_pk_bf16(o[2], o[3]); \
                *(u32x2*)(P.Y + (row0 + 16 * (size_t)(pc) + tk) * D + hd * 64 + 4 * fr) = w_; } while (0)
            SC_LOAD(0); SC_PROC(0); SC_LOAD(1);
            BAR_LDS();
            int cb = 0;
            for (int c = 0; c < S / 16; ++c) {
                const int nb = cb == 2 ? 0 : cb + 1, pb = cb == 0 ? 2 : cb - 1;
                if (c + 1 < S / 16) SC_PROC(nb);
                if (c + 2 < S / 16) SC_LOAD(c + 2);
                if (c >= 1) SC_POST(c - 1, pb);
                BAR_LDS();
                cb = nb;
            }
            { const int pb = cb == 0 ? 2 : cb - 1; SC_POST(S / 16 - 1, pb); }
#undef SC_LOAD
#undef SC_PROC
#undef SC_POST
        }
        BAR_LDS();
    }
}

#define XB_TMO      128
#define XB_XCNT(j)  (256  + 64 * (j))
#define XB_XSUB(j)  (1280 + 64 * (j))
#define XB_XGEN(j)  (2304 + 64 * (j))
#define XB_TOP      3328
#define XB_TOPGEN   3392
#define XCD_BAR_WORDS 3456
#define XB_SPIN_CAP (1u << 18)

__device__ __forceinline__ unsigned xb_ld(unsigned* p)              { return __hip_atomic_load(p, __ATOMIC_RELAXED, __HIP_MEMORY_SCOPE_AGENT); }
__device__ __forceinline__ unsigned xb_add(unsigned* p, unsigned v) { return __hip_atomic_fetch_add(p, v, __ATOMIC_RELAXED, __HIP_MEMORY_SCOPE_AGENT); }
__device__ __forceinline__ unsigned xb_xcc_id() { return (unsigned)__builtin_amdgcn_s_getreg((3 << 11) | 20) & 0xFu; }
#define XB_SPIN(cond, bar) do { unsigned _sp = 0; while (cond) { __builtin_amdgcn_s_sleep(1); \
    if ((++_sp & 255u) == 0u) { if (xb_ld(&(bar)[XB_TMO])) break; if (_sp > XB_SPIN_CAP) { atomicAdd(&(bar)[XB_TMO], 1u); break; } } } } while (0)

struct XcdBarrier {
    unsigned* bar; unsigned x;
    volatile LAS unsigned* st;
};

__device__ __forceinline__ XcdBarrier xcd_barrier_post(unsigned* bar, volatile LAS unsigned* st) {
    XcdBarrier b; b.bar = bar; b.x = xb_xcc_id(); b.st = st;
    if (threadIdx.x == 0) (void)xb_add(&bar[XB_XCNT(b.x)], 1u);
    return b;
}
__device__ __forceinline__ void xcd_barrier_complete(unsigned* bar, unsigned x, unsigned& nloc, unsigned& nx) {
    const unsigned G = gridDim.x * gridDim.y * gridDim.z;
    unsigned sum, cnt, mine, sp = 0u;
    for (;;) {
        sum = 0u; cnt = 0u; mine = 0u;
#pragma unroll
        for (unsigned j = 0; j < 16; ++j) { const unsigned c = xb_ld(&bar[XB_XCNT(j)]); sum += c; cnt += (c > 0u) ? 1u : 0u; mine = (j == x) ? c : mine; }
        if (sum == G) break;
        __builtin_amdgcn_s_sleep(1);
        if ((++sp & 255u) == 0u) { if (xb_ld(&bar[XB_TMO])) break; if (sp > XB_SPIN_CAP) { atomicAdd(&bar[XB_TMO], 1u); break; } }
    }
    nloc = mine > 0u ? mine : 1u; nx = cnt > 0u ? cnt : 1u;
}

__device__ __forceinline__ void xcd_barrier(const XcdBarrier& b) {
    asm volatile("s_waitcnt vmcnt(0)" ::: "memory");
    __syncthreads();
    if (threadIdx.x == 0) {
        unsigned* bar = b.bar;
        __builtin_amdgcn_s_waitcnt(0);
        unsigned nloc = b.st[0], nx = b.st[1];
        if (nloc == 0u) { xcd_barrier_complete(bar, b.x, nloc, nx); b.st[0] = nloc; b.st[1] = nx; }
        const unsigned old = xb_add(&bar[XB_XSUB(b.x)], 1u);
        const unsigned gen = old / nloc;
        if (old + 1u == (gen + 1u) * nloc) {
            __builtin_amdgcn_fence(__ATOMIC_RELEASE, "agent");
            asm volatile("s_waitcnt vmcnt(0)" ::: "memory");
            const unsigned og = xb_add(&bar[XB_TOP], 1u);
            const unsigned tg = og / nx;
            if (og + 1u == (tg + 1u) * nx) xb_add(&bar[XB_TOPGEN], 1u);
            else XB_SPIN(xb_ld(&bar[XB_TOPGEN]) == tg, bar);
            __builtin_amdgcn_fence(__ATOMIC_ACQUIRE, "agent");
            xb_add(&bar[XB_XGEN(b.x)], 1u);
            asm volatile("s_waitcnt vmcnt(0)" ::: "memory");
        } else {
            XB_SPIN(xb_ld(&bar[XB_XGEN(b.x)]) == gen, bar);
            __builtin_amdgcn_fence(__ATOMIC_ACQUIRE, "agent");
            asm volatile("s_waitcnt vmcnt(0)" ::: "memory");
        }
    }
    __syncthreads();
}

struct Args { const float* in[36]; float* out; unsigned char* ws; };
#ifndef DBG
#define DBG 0
#endif
__device__ __forceinline__ void dbg_dump(float* out, const bf16_t* A, const bf16_t* B, const bf16_t* C, const bf16_t* L, int g0, int gn) {
    for (size_t i = g0; i < (size_t)T * D; i += gn) { float s = 0.f; if (A) s += bf2f(A[i]); if (B) s += bf2f(B[i]); if (C) s += bf2f(C[i]); if (L) s += bf2f(L[(i >> 10) * 512 + (i & 511)]); out[i] = s; }
}
enum { I_X = 0, I_C, I_ADAW, I_ADAB, I_N1, I_N2, I_FN, I_MU, I_WRKV, I_W0, I_W1, I_W2, I_A0, I_A1, I_A2, I_V0, I_V1, I_V2, I_G1, I_G2, I_KK, I_KA, I_RK, I_LNW, I_LNB, I_WOA,
       I_KVN, I_WKV, I_WQ, I_LAM, I_SUBLN, I_WOB, I_UP, I_CW, I_CB, I_DN };

__global__ void __launch_bounds__(NTHR, 2) yoco_fwd(Args a) {
    extern __shared__ __attribute__((aligned(16))) unsigned char lds_raw[];
    LAS unsigned char* lds = (LAS unsigned char*)lds_raw;
    cg::grid_group grid = cg::this_grid();
#define OPQ(x) ({ int o_ = (x); asm volatile("" : "+s"(o_)); o_; })
#define TIDX() ({ int t_ = threadIdx.x; asm volatile("" : "+v"(t_)); t_; })
#define tid TIDX()
#define lane (TIDX() & 63)
#define gtid (bx * NTHR + TIDX())
    const int wave = __builtin_amdgcn_readfirstlane((int)threadIdx.x >> 6);
    const int G = gridDim.x, bx = blockIdx.x, gw = bx * NWAVES + wave, NGW = G * NWAVES, NTOT = G * NTHR;
    unsigned char* ws = a.ws;
    LAS unsigned long long* ptab = (LAS unsigned long long*)(lds + 131072);
    if (tid == 0) {
#pragma unroll
        for (int i = 0; i < 36; ++i) ptab[i] = (unsigned long long)(uintptr_t)a.in[i]; }
    if (TIDX() < 64) ((LAS unsigned*)(lds + 131072 + 512))[TIDX()] = 0u;
    __syncthreads();
    grid.sync();
    (void)xcd_barrier_post((unsigned*)(ws + WS_CTL), (volatile LAS unsigned*)(lds + 131072 + 512) + 8);
#define PTABW(i) ({ unsigned o_ = 131072u + 8u * (unsigned)(i); asm volatile("" : "+v"(o_)); *(LAS unsigned long long*)o_; })
#define INP(i) ({ const unsigned long long w_ = PTABW(i); (const float*)(uintptr_t)(((unsigned long long)(unsigned)__builtin_amdgcn_readfirstlane((int)(w_ >> 32)) << 32) | (unsigned long long)(unsigned)__builtin_amdgcn_readfirstlane((int)(unsigned)w_)); })
    bf16_t* Wb = (bf16_t*)(ws + WS_W); bf16_t* H = (bf16_t*)(ws + WS_H);
    float* MOD = (float*)(ws + WS_MOD); float* ROPE = (float*)(ws + WS_ROPE); float* MODP = (float*)(ws + WS_MODP);
    float* out = a.out;
#define SYNC() do { XcdBarrier b_; b_.bar = (unsigned*)(ws + WS_CTL); b_.x = xb_xcc_id(); b_.st = (volatile LAS unsigned*)(lds + 131072 + 512) + 8; xcd_barrier(b_); } while (0)

    {
        LAS float* cact = (LAS float*)(lds + 69632);
        for (int i = tid; i < NB * D; i += NTHR) { const float c = INP(I_C)[i]; cact[(i & (D - 1)) * 8 + (i >> 10)] = c / (1.f + expf(-c)); }
        __syncthreads();
        for (int i = gtid; i < NB * 8 * 128; i += NTOT) { const int b = i >> 10, r = (i >> 7) & 7, c8 = i & 127; *(u32x4*)(H + ((size_t)b * SP + r) * D + 8 * c8) = (u32x4){0u, 0u, 0u, 0u}; }
        for (int i = gtid; i < S * 8; i += NTOT) { const float ang = (float)(i >> 3) * rope_inv(i & 7); ROPE[i] = cosf(ang); ROPE[S * 8 + i] = sinf(ang); }
        for (int it = gw; it < 4 * 24 * 32; it += NGW) {
            const int ks = it & 31, cc = (it >> 5) % 24, l = it / (32 * 24);
            f32x4 acc[8];
#pragma unroll
            for (int b = 0; b < 8; ++b) acc[b] = (f32x4){0.f, 0.f, 0.f, 0.f};
            const float* wp = INP(I_ADAW) + ((size_t)l * D + 32 * ks) * 6144 + 256 * cc + 4 * lane;
#pragma unroll 8
            for (int kk = 0; kk < 32; ++kk) { const f32x4 w = *(const f32x4*)(wp + (size_t)kk * 6144); const LAS float* cp = cact + (32 * ks + kk) * 8;
                const f32x4 c0 = *(const LAS f32x4*)cp, c1 = *(const LAS f32x4*)(cp + 4);
                acc[0] += w * c0.x; acc[1] += w * c0.y; acc[2] += w * c0.z; acc[3] += w * c0.w; acc[4] += w * c1.x; acc[5] += w * c1.y; acc[6] += w * c1.z; acc[7] += w * c1.w; }
#pragma unroll
            for (int b = 0; b < 8; ++b) *(f32x4*)(MODP + ((size_t)(ks * 4 + l) * 8 + b) * 6144 + 256 * cc + 4 * lane) = acc[b];
        }
        LAS Job* jobs = (LAS Job*)(lds + 102400); int nj = 0, tot = 0;
#define ADDJOB(W_, mu_, Bt_, ldw_, K_, N_, ldb_, kdst0_, mode_, map_, rowoff_) do { if (tid == 0) { LAS Job* jb = jobs + nj; jb->W = (W_); jb->mu = (mu_); jb->Bt = (Bt_); jb->ldw = (ldw_); jb->K = (K_); jb->N = (N_); \
            jb->ldb = (ldb_); jb->kdst0 = (kdst0_); jb->mode = (mode_); jb->map = (map_); jb->rowoff = (rowoff_); jb->start = tot; } tot += ((K_) / 64) * ((N_) / 32); ++nj; asm volatile("" ::: "memory"); } while (0)
        for (int l = 0; l < 2; ++l) {
            const float* mu = INP(I_MU) + (size_t)l * 6 * D; bf16_t* B = Wb + we_rkvl(l);
            for (int i = 0; i < 3; ++i) { const float* W = INP(I_WRKV) + (size_t)(l * 3 + i) * D * D; const float* m = mu + (i == 0 ? 0 : (i == 1 ? 2 : 3)) * D;
                ADDJOB(W, m, B, D, D, D, 2048, 0, 1, 0, i * D); ADDJOB(W, m, B, D, D, D, 2048, D, 2, 0, i * D); }
            ADDJOB(INP(I_W1) + (size_t)l * D * 64, mu + 1 * D, B, 64, D, 64, 2048, 0, 1, 0, 3072); ADDJOB(INP(I_W1) + (size_t)l * D * 64, mu + 1 * D, B, 64, D, 64, 2048, D, 2, 0, 3072);
            ADDJOB(INP(I_A1) + (size_t)l * D * 64, mu + 4 * D, B, 64, D, 64, 2048, 0, 1, 0, 3136); ADDJOB(INP(I_A1) + (size_t)l * D * 64, mu + 4 * D, B, 64, D, 64, 2048, D, 2, 0, 3136);
            if (l == 1) { ADDJOB(INP(I_V1), mu + 3 * D, B, 32, D, 32, 2048, 0, 1, 0, 3200); ADDJOB(INP(I_V1), mu + 3 * D, B, 32, D, 32, 2048, D, 2, 0, 3200); }
            ADDJOB(INP(I_G1) + (size_t)l * D * 160, mu + 5 * D, B, 160, D, 160, 2048, 0, 1, 0, 3232); ADDJOB(INP(I_G1) + (size_t)l * D * 160, mu + 5 * D, B, 160, D, 160, 2048, D, 2, 0, 3232);
            ADDJOB(INP(I_WOA) + (size_t)l * D * D, nullptr, Wb + we_woa(l), D, D, D, D, 0, 0, 0, 0);
        }
        for (int l = 0; l < 4; ++l) {
            ADDJOB(INP(I_UP) + (size_t)l * D * FF2, nullptr, Wb + we_up(l), FF2, D, FF2, D, 0, 0, 1, 0);
            ADDJOB(INP(I_DN) + (size_t)l * FF * D, nullptr, Wb + we_dn(l), D, FF, D, FF, 0, 0, 0, 0);
        }
        ADDJOB(INP(I_WKV), nullptr, Wb + WE_KV, 2048, D, D, D, 0, 0, 2, 0); ADDJOB(INP(I_WKV) + D, nullptr, Wb + WE_KV, 2048, D, D, D, 0, 0, 0, D);
        for (int j = 0; j < 2; ++j) { ADDJOB(INP(I_WQ) + (size_t)j * D * D, nullptr, Wb + we_q(j), D, D, D, D, 0, 0, 2, 0); ADDJOB(INP(I_WOB) + (size_t)j * D * D, nullptr, Wb + we_ob(j), D, D, D, D, 0, 0, 0, 0); }
#undef ADDJOB
        __syncthreads();
        LAS float* scr = (LAS float*)(lds + wave * 8704); int jn = 0;
        {
            float va[32], vb[32]; int it = gw, jc = 0, ic = 0;
            if (it < tot) { while (jn + 1 < nj && jobs[jn + 1].start <= it) ++jn; jc = jn; ic = it - jobs[jn].start; tr_load(jobs + jc, ic, va, lane); }
            while (it < tot) {
                int it2 = it + NGW, j2 = jc, i2 = 0;
                if (it2 < tot) { while (jn + 1 < nj && jobs[jn + 1].start <= it2) ++jn; j2 = jn; i2 = it2 - jobs[jn].start; tr_load(jobs + j2, i2, vb, lane); }
                tr_store(jobs + jc, ic, va, scr, lane);
                it = it2 + NGW; jc = j2; ic = i2;
                if (it2 >= tot) break;
                int j3 = jc, i3 = 0;
                if (it < tot) { while (jn + 1 < nj && jobs[jn + 1].start <= it) ++jn; j3 = jn; i3 = it - jobs[jn].start; tr_load(jobs + j3, i3, va, lane); }
                tr_store(jobs + jc, ic, vb, scr, lane);
                jc = j3; ic = i3;
            }
        }
        for (int i = gtid; i < 2 * 40 * D; i += NTOT) { const int l = i / (40 * D), r = i % (40 * D), kg = r >> 10, n = r & (D - 1), k = 8 * kg;
            const float* src = nullptr;
            if (k < 64) src = INP(I_W2) + ((size_t)l * 64 + k) * D; else if (k < 128) src = INP(I_A2) + ((size_t)l * 64 + (k - 64)) * D;
            else if (k < 160) src = (l == 1) ? INP(I_V2) + (size_t)(k - 128) * D : nullptr; else src = INP(I_G2) + ((size_t)l * 160 + (k - 160)) * D;
            float f[8];
#pragma unroll
            for (int e = 0; e < 8; ++e) f[e] = src ? src[(size_t)e * D + n] : 0.f;
            u32x4 w; w.x = cvt_pk_bf16(f[0], f[1]); w.y = cvt_pk_bf16(f[2], f[3]); w.z = cvt_pk_bf16(f[4], f[5]); w.w = cvt_pk_bf16(f[6], f[7]);
            *(u32x4*)(Wb + we_lb(l) + (size_t)n * 320 + k) = w; }
    }
    SYNC();
    {
        for (int i = gtid; i < 4 * 8 * 6144; i += NTOT) { const int n = i % 6144, l = i / (8 * 6144); float s = INP(I_ADAB)[l * 6144 + n];
#pragma unroll 8
            for (int ks = 0; ks < 32; ++ks) s += MODP[(size_t)ks * (4 * 8 * 6144) + i];
            MOD[i] = s; }
    }
    SYNC();

#define BIAS_WORK(W0_, NW_) do { \
                for (int i = (W0_) * 64 + lane; i < D; i += (NW_) * 64) ((float*)(ws + WS_KVNC))[i] = INP(I_KVN)[i]; \
                for (int rw = (W0_); rw < 4 * FF2 + 2 * D; rw += (NW_)) { \
                    const bool up = rw < 4 * FF2; const int jq = up ? 0 : (rw - 4 * FF2) / D; const int lw = up ? rw / FF2 : 2 + jq, r = up ? rw % FF2 : (rw - 4 * FF2) % D; \
                    const bf16_t* Brow = (up ? Wb + we_up(lw) : Wb + we_q(jq)) + (size_t)r * D + 16 * lane; \
                    const float* shp = MOD + (size_t)lw * 8 * 6144 + (up ? 3072 : 0) + 16 * lane; \
                    float* dst = up ? (float*)(ws + WS_BIASUP) + (size_t)lw * 8 * FF2 + r : (float*)(ws + WS_BIASQ) + (size_t)jq * 8 * D + r; const int dstr = up ? FF2 : D; \
                    const u32x4 w0 = *(const u32x4*)Brow, w1 = *(const u32x4*)(Brow + 8); float wv[16]; \
_Pragma("unroll") \
                    for (int e = 0; e < 4; ++e) { wv[2 * e] = __uint_as_float(w0[e] << 16); wv[2 * e + 1] = __uint_as_float(w0[e] & 0xffff0000u); wv[8 + 2 * e] = __uint_as_float(w1[e] << 16); wv[9 + 2 * e] = __uint_as_float(w1[e] & 0xffff0000u); } \
                    for (int b = 0; b < 8; ++b) { float sacc = 0.f; \
_Pragma("unroll") \
                        for (int e = 0; e < 4; ++e) { const f32x4 sv = *(const f32x4*)(shp + (size_t)b * 6144 + 4 * e); sacc += (wv[4 * e] * sv[0] + wv[4 * e + 1] * sv[1]) + (wv[4 * e + 2] * sv[2] + wv[4 * e + 3] * sv[3]); } \
                        sacc = wave_sum_dpp(sacc); if (lane == 0) dst[(size_t)b * dstr] = sacc; } \
                } \
} while (0)
    for (int l = 0; l < 4; ++l) {
        const float* xin = (l == 0) ? INP(I_X) : out;
        const float* modl = MOD + (size_t)l * 8 * 6144;
        if (l < 2) {
            norm_phase(xin, INP(I_N1) + (size_t)l * D, modl, 0, 1024, H, nullptr, nullptr, gw, NGW, lane);
            if (l == 0) {
                if (G <= NB * 16) BIAS_WORK(gw, NGW);
            }
            SYNC();
        }
        bf16_t* mixo;
        if (l < 2) {
            bf16_t* Rb = (bf16_t*)(ws + WS_R); bf16_t* Kb = (bf16_t*)(ws + WS_K); bf16_t* Vb = (bf16_t*)(ws + (l == 0 ? WS_VF : WS_V1)); bf16_t* Lb = (bf16_t*)(ws + WS_L);
            {
                pg8::Gemm g; g.A = (const char*)(H + (size_t)8 * D); g.Bt = Wb + we_rkvl(l); g.K = 2048; g.lda = D;
                pg8::StaticOrder So; So.init(T / 256, (int)NRKVL / 256, OPQ(G), OPQ(bx));
                EpiRkvL E{Rb, Kb, Vb, Lb};
                pg8::gemm_phase<EpiRkvL, pg8::StaticOrder, true, true, 16, false, true>(lds, g, So, E);
            }
            SYNC();
            if (DBG == 1) { dbg_dump(out, Rb, Kb, Vb, Lb, gtid, NTOT); return; }
            {
                ScanP P; P.R = Rb; P.K = Kb; P.V = Vb; P.VF = (const bf16_t*)(ws + WS_VF); P.L = Lb; P.Y = Rb; P.LB = Wb + we_lb(l);
                P.w0 = INP(I_W0) + (size_t)l * D; P.a0 = INP(I_A0) + (size_t)l * D; P.v0 = INP(I_V0); P.kk = INP(I_KK) + (size_t)l * D; P.ka = INP(I_KA) + (size_t)l * D;
                P.rk = INP(I_RK) + (size_t)l * D; P.lnw = INP(I_LNW) + (size_t)l * D; P.lnb = INP(I_LNB) + (size_t)l * D; P.vres = (l == 1);
                scan_phase(lds, P, OPQ(G));
                if (l == 0 && OPQ(G) > NB * 16 && OPQ(bx) >= NB * 16) BIAS_WORK((bx - NB * 16) * NWAVES + wave, (G - NB * 16) * NWAVES);
            }
            mixo = Rb;
            if (DBG == 2) { SYNC(); return; }
        } else {
            const int j = l - 2;
            bf16_t* Qb = (bf16_t*)(ws + WS_Q); bf16_t* KSb = (bf16_t*)(ws + WS_KS); bf16_t* VSb = (bf16_t*)(ws + WS_VS); bf16_t* O0 = (bf16_t*)(ws + WS_O0); bf16_t* O1 = (bf16_t*)(ws + WS_O1);
            for (int gi = 0; gi < (j == 0 ? 2 : 1); ++gi) {
                pg8::Gemm g; g.A = (const char*)((gi == 0 ? H : (bf16_t*)(ws + WS_HK)) + (size_t)8 * D); g.Bt = gi == 0 ? Wb + we_q(j) : Wb + WE_KV; g.K = D; g.lda = D;
                pg8::StaticOrder So; So.init(T / 256, gi == 0 ? 4 : 8, OPQ(G), OPQ(bx));
                EpiRope E{ws, (unsigned)(gi == 0 ? WS_Q : WS_KS), (unsigned)WS_VS, (unsigned)(WS_SS + (l == 3 ? 4 : 5) * (size_t)T * 4), (unsigned)(WS_BIASQ + (size_t)j * 8 * D * 4), gi == 0 ? attn_body::C2 : 1.f, 1, gi == 0 ? 1 : 0};
                pg8::gemm_phase<EpiRope, pg8::StaticOrder, true, true, 16, false, false>(lds, g, So, E);
            }
            SYNC();
            {
                const int G_ = OPQ(G), bx_ = OPQ(bx); const int vcu = (G_ % 8 == 0) ? (bx_ % 8) * (G_ / 8) + bx_ / 8 : bx_;
                for (int combo = vcu; combo < 256; combo += G_) { const int b = combo >> 5, vhd = (combo >> 1) & 15, vh = combo & 1;
                    for (int qb = S / 256 - 1; qb >= 0; --qb)
                        attn_body::attn_unit<8>(b, vhd * 64, (vhd >> 1) * 128 + vh * 64, qb, (const attn_body::bf16*)Qb, (const attn_body::bf16*)KSb, (const attn_body::bf16*)VSb, (attn_body::bf16*)((vhd & 1) ? O1 : O0), (char*)lds_raw); }
            }
            SYNC();
            combine_phase(O0, O1, INP(I_LAM) + (size_t)j * 256, INP(I_SUBLN) + (size_t)j * 128, 0.8f - 0.6f * expf(-0.3f * (float)l), gw, NGW, lane);
            mixo = O0;
        }
        SYNC();
        for (int pass = 0; pass < 2; ++pass) {
            const size_t act_off = l == 0 ? WS_ACT_R : (l == 1 ? WS_A : WS_ACT_B);
            bf16_t* ACT = (bf16_t*)(ws + act_off);
            if (pass) {
                {
                    pg8::Gemm g; g.A = (const char*)(H + (size_t)6 * D); g.Bt = Wb + we_up(l); g.K = D; g.lda = D;
                    pg8::StaticOrder So; So.init(NB * 17, FF2 / 256, OPQ(G), OPQ(bx));
                    EpiUp E{ws, INP(I_CW) + (size_t)l * 3 * FF2, INP(I_CB) + (size_t)l * FF2, (unsigned)act_off, (unsigned)(WS_SS + (size_t)l * T * 4), (unsigned)(WS_BIASUP + (size_t)l * 8 * FF2 * 4)};
                    pg8::gemm_phase<EpiUp, pg8::StaticOrder, true, true, 17, true, false>(lds, g, So, E);
                }
                SYNC();
                if (DBG == 4) { for (size_t i = gtid; i < (size_t)T * D; i += NTOT) out[i] = bf2f(ACT[(i >> 10) * FF + (i & 1023)]) + bf2f(ACT[(i >> 10) * FF + 1024 + (i & 1023)]) + bf2f(ACT[(i >> 10) * FF + 1792 + (i & 1023)]); return; }
            }
            {
                pg8::Gemm g; g.A = (const char*)(pass ? ACT : mixo); g.Bt = pass ? Wb + we_dn(l) : (l < 2 ? Wb + we_woa(l) : Wb + we_ob(l - 2)); g.K = pass ? FF : D; g.lda = g.K;
                pg8::StaticOrder So; So.init(T / 256, 4, OPQ(G), OPQ(bx));
                const int nx = pass == 0 ? 1 : (l == 1 ? 2 : (l == 2 ? 1 : 0));
                EpiRes E{(l == 0 && pass == 0) ? INP(I_X) : out, out, ws, pass == 0 ? INP(I_N2) + (size_t)l * D : INP(I_N1) + (size_t)(l + 1 < 4 ? l + 1 : 3) * D, (unsigned)(WS_MOD + ((size_t)l * 8 * 6144 + (pass ? 5120 : 2048)) * 4),
                         (unsigned)(WS_MOD + (pass == 0 ? (size_t)l * 8 * 6144 + 4096 : (size_t)(l + 1 < 4 ? l + 1 : 3) * 8 * 6144 + 1024) * 4), (unsigned)(WS_SS + (pass == 0 ? (size_t)l : (l == 2 ? (size_t)4 : (size_t)5)) * T * 4), nx};
                pg8::gemm_phase<EpiRes, pg8::StaticOrder, true, true, 0, false, false>(lds, g, So, E);
            }
            SYNC();
            if (DBG == 3 && pass == 0) return;
            if (DBG == 5 && pass == 1) return;
            if (DBG == 6 && pass == 1 && l == 1) return;
            if (DBG == 7 && pass == 1 && l == 2) return;
        }
    }
    final_norm_phase(out, INP(I_FN), gw, NGW, lane);
#undef tid
#undef lane
#undef gtid
}

extern "C" void kernel_launch(void* const* d_in, const int* in_sizes, int n_in, void* d_out, int out_size, void* d_ws, size_t ws_size, hipStream_t stream) {
    static int grid = 0;
    if (grid == 0) {
        if (n_in != 36 || out_size != T * D || ws_size < WS_END) { fprintf(stderr, "kernel_launch: unexpected problem (n_in %d, out %d, ws %zu < %zu)\n", n_in, out_size, ws_size, (size_t)WS_END); grid = -1; return; }
        int dev = 0, cus = 0, per_cu = 0;
        hipGetDevice(&dev); hipDeviceGetAttribute(&cus, hipDeviceAttributeMultiprocessorCount, dev);
        if (hipFuncSetAttribute((const void*)yoco_fwd, hipFuncAttributeMaxDynamicSharedMemorySize, LDS_BYTES) != hipSuccess) { fprintf(stderr, "kernel_launch: hipFuncSetAttribute failed\n"); grid = -1; return; }
        if (hipOccupancyMaxActiveBlocksPerMultiprocessor(&per_cu, (const void*)yoco_fwd, NTHR, LDS_BYTES) != hipSuccess || per_cu < 1) { fprintf(stderr, "kernel_launch: occupancy query failed (%d)\n", per_cu); (void)hipGetLastError(); per_cu = 1; }
        grid = cus * per_cu;
    }
    if (grid < 0) return;
    if (hipMemsetAsync((char*)d_ws + WS_CTL, 0, 1048576, stream) != hipSuccess) { fprintf(stderr, "kernel_launch: memset failed\n"); return; }
    Args a{};
    for (int i = 0; i < 36; ++i) a.in[i] = (const float*)d_in[i];
    a.out = (float*)d_out; a.ws = (unsigned char*)d_ws;
    void* args[] = {&a};
    hipError_t e = hipLaunchCooperativeKernel((const void*)yoco_fwd, dim3(grid), dim3(NTHR), args, LDS_BYTES, stream);
    if (e != hipSuccess) fprintf(stderr, "kernel_launch: cooperative launch failed: %s (grid %d)\n", hipGetErrorString(e), grid);
}
```

```cpp
#include <hip/hip_runtime.h>
#include <hip/hip_cooperative_groups.h>
#include <cstdio>
#include <cstdint>
namespace cg = cooperative_groups;
namespace pg8 {
#define PG8_LAS __attribute__((address_space(3)))
typedef unsigned short bf16_t;
typedef short bf16x8 __attribute__((ext_vector_type(8)));
typedef float f32x4 __attribute__((ext_vector_type(4)));
typedef unsigned u32x4 __attribute__((ext_vector_type(4)));
constexpr int BM = 256, BK = 64, HALF = 128, HTB = HALF * BK * 2  , STAGE_BYTES = 8 * HTB, NXCD = 8, WGM = 8;

__host__ __device__ __forceinline__ int lds_byte(int r, int c) { const int st = (r >> 4) * 2 + (c >> 5), rr = r & 15, cc = c & 31, ob = rr * 64 + cc * 2; return st * 1024 + (ob ^ (((ob >> 9) & 1) << 5)); }
__host__ __device__ __forceinline__ void stage_rc(int b, int& R, int& C) { const int st = b / 1024, sb = b % 1024, swz = sb ^ (((sb >> 9) & 1) << 5); R = (st >> 1) * 16 + swz / 64; C = (st & 1) * 32 + (swz % 64) / 2; }
__host__ __device__ __forceinline__ int perm32(int rho) { const int n = rho >> 4, i = rho & 15; return 8 * (i >> 2) + 4 * n + (i & 3); }

struct Unit { int pm, pn; };
struct Gemm { const char* A; const bf16_t* Bt; int K, lda; };

struct StaticOrder {
    int nM, nN, nwg, G, c;
    __host__ __device__ void init(int nM_, int nN_, int G_, int c_) { nM = nM_; nN = nN_; nwg = nM * nN; G = G_; c = c_; }
    __host__ __device__ bool next(int i, Unit& u) const {
        const long L = (long)i * G + c; if (L >= nwg) return false;
        int wgid = (int)L; { const int q = nwg / NXCD, r = nwg % NXCD, xcd = wgid % NXCD, off = wgid / NXCD; wgid = (xcd < r ? xcd * (q + 1) : r * (q + 1) + (xcd - r) * q) + off; }
        const int nig = WGM * nN, gid = wgid / nig, fm = gid * WGM, gsz = (nM - fm) < WGM ? (nM - fm) : WGM;
        u.pm = fm + ((wgid % nig) % gsz); u.pn = (wgid % nig) / gsz; return true;
    }
    __device__ __forceinline__ void a_ready(const Unit&) const {}
    __device__ __forceinline__ void done(const Unit&) const {}
};

__device__ __forceinline__ unsigned cvt_pk_bf16(float lo, float hi) { unsigned r; asm volatile("v_cvt_pk_bf16_f32 %0, %1, %2" : "=v"(r) : "v"(lo), "v"(hi)); return r; }
typedef float f32x2 __attribute__((ext_vector_type(2)));
__device__ __forceinline__ f32x2 gelu_pk(f32x2 v) {
    const f32x2 av = __builtin_elementwise_abs(v), d = av * 0.2316418882f + 1.0f;
    f32x2 t; t.x = __builtin_amdgcn_rcpf(d.x); t.y = __builtin_amdgcn_rcpf(d.y);
    f32x2 q = t * 0.5307027145f + (-0.7265760135f); q = q * t + 0.7107068705f; q = q * t + (-0.142248368f); q = q * t + 0.127414796f; q = q * t;
    const f32x2 s = (v * v) * (-0.72134752044f);
    f32x2 e; e.x = __builtin_amdgcn_exp2f(s.x); e.y = __builtin_amdgcn_exp2f(s.y);
    const f32x2 m = v * (q * e), r = v - m;
    f32x2 o; o.x = v.x < 0.f ? m.x : r.x; o.y = v.y < 0.f ? m.y : r.y; return o;
}

template <int ACT  > struct EpiBf16 {
    static constexpr bool PERM = true, AFTER_DRAIN = false; static_assert(ACT == 0 || ACT == 1, "EpiBf16: ACT is 0 (none) or 1 (gelu_pk)");
    bf16_t* O; int ldc; const float* bias; int split_cols; size_t split_stride; float scale0;
    __device__ __forceinline__ void operator()(const f32x4 (&acc)[2][2][4][2], const Unit& u, int wr, int wc, int fr, int fq) const {
        const int row0 = u.pm * BM + wr * 64 + fr; int colt = u.pn * BM; bf16_t* base = O;
        float sc = 1.f; if (split_cols) { const int t = colt / split_cols; base += (size_t)t * split_stride; colt -= t * split_cols; if (t == 0) sc = scale0; }
        const int col0 = colt + wc * 32 + 8 * fq, bcol0 = u.pn * BM + wc * 32 + 8 * fq;
        f32x4 bv[2][2];
#pragma unroll
        for (int bj = 0; bj < 2; ++bj)
#pragma unroll
            for (int n = 0; n < 2; ++n) bv[bj][n] = bias ? *(const f32x4*)(bias + bcol0 + bj * HALF + 4 * n) : (f32x4){0.f, 0.f, 0.f, 0.f};
#pragma unroll
        for (int ai = 0; ai < 2; ++ai)
#pragma unroll
            for (int m = 0; m < 4; ++m) { bf16_t* rowp = base + (size_t)(row0 + ai * HALF + m * 16) * ldc + col0;
#pragma unroll
                for (int bj = 0; bj < 2; ++bj) { f32x4 v0 = acc[ai][bj][m][0] + bv[bj][0], v1 = acc[ai][bj][m][1] + bv[bj][1];
                    if (ACT == 1) { f32x2 a = gelu_pk((f32x2){v0[0], v0[1]}), b = gelu_pk((f32x2){v0[2], v0[3]}), c = gelu_pk((f32x2){v1[0], v1[1]}), d = gelu_pk((f32x2){v1[2], v1[3]});
                        v0 = (f32x4){a.x, a.y, b.x, b.y}; v1 = (f32x4){c.x, c.y, d.x, d.y}; }
                    v0 = v0 * sc; v1 = v1 * sc; u32x4 w; w.x = cvt_pk_bf16(v0[0], v0[1]); w.y = cvt_pk_bf16(v0[2], v0[3]); w.z = cvt_pk_bf16(v1[0], v1[1]); w.w = cvt_pk_bf16(v1[2], v1[3]);
                    *(u32x4*)(rowp + bj * HALF) = w; } }
    }
};
template <class Epi, class Sched, bool ALIGN_EPI, bool SP2, int UPB  , bool HALO, bool WRAP>
__device__ __forceinline__ void gemm_phase(PG8_LAS unsigned char* lds, const Gemm g, const Sched& S, const Epi& E) {
    int tid_o_ = threadIdx.x; asm volatile("" : "+v"(tid_o_)); const int tid = tid_o_, wid = __builtin_amdgcn_readfirstlane(tid >> 6), lane = tid & 63, wr = wid >> 2, wc = wid & 3, fr = lane & 15, fq = lane >> 4;
    const int K = g.K, nt = K / BK;
    unsigned voffA[2], voffB[2];
#pragma unroll
    for (int i = 0; i < 2; ++i) { int R, C; stage_rc(tid * 16 + i * 8192, R, C); const int Rb = Epi::PERM ? ((R & ~31) + perm32(R & 31)) : R;
        const int Ra = HALO ? (R - 2 * (R >> 6)) : R; voffA[i] = (unsigned)(Ra * g.lda + C) * 2u; voffB[i] = (unsigned)(Rb * K + C) * 2u; }
    const size_t kstep = (size_t)(BK * 2);
    const size_t hstep = (size_t)HALF * K * 2;
    const size_t hstepA = (size_t)((HALO ? 124 : 128) * g.lda * 2);
#define PG8_KOFFA(t) ((long)(t) * (long)kstep + ((WRAP && (t) >= 16) ? -(long)(16 * 128 + 2048) : 0l))
#define PG8_APTR(pm) (UPB ? (g.A + (size_t)((pm) / (UPB ? UPB : 1)) * (size_t)(4104 * 2048) + (size_t)((pm) % (UPB ? UPB : 1)) * (size_t)((HALO ? 248 : 256) * 2048)) : (g.A + (size_t)(pm) * (size_t)(256 * 2) * (size_t)g.lda))
    const size_t tstep = 2 * hstep;
    const unsigned ldsw = (unsigned)wid * 1024u;
    const int aoff = lds_byte(wr * 64 + fr, fq * 8), boff = lds_byte(wc * 32 + fr, fq * 8);
#define PG8_SA(b, h) (((b) * 2 + (h)) * HTB)
#define PG8_SB(b, h) ((4 + (b) * 2 + (h)) * HTB)
#define PG8_STAGE(bufoff, gbase, voff) do { _Pragma("unroll") for (int _i = 0; _i < 2; ++_i) \
        __builtin_amdgcn_global_load_lds((const unsigned*)((const char*)(gbase) + (voff)[_i]), (PG8_LAS unsigned*)(lds + (bufoff) + ldsw + _i * 8192), 16, 0, 0); } while (0)
#define PG8_LDA(dst, b, h) do { _Pragma("unroll") for (int m = 0; m < 4; ++m) _Pragma("unroll") for (int k = 0; k < 2; ++k) dst[m][k] = *(const PG8_LAS bf16x8*)(lds + PG8_SA(b, h) + aoff + m * 2048 + k * 1024); } while (0)
#define PG8_LDB(dst, b, h) do { _Pragma("unroll") for (int n = 0; n < 2; ++n) _Pragma("unroll") for (int k = 0; k < 2; ++k) dst[n][k] = *(const PG8_LAS bf16x8*)(lds + PG8_SB(b, h) + boff + n * 2048 + k * 1024); } while (0)
#define PG8_MMA(ai, bj, At, Bt) do { __builtin_amdgcn_s_setprio(1); _Pragma("unroll") for (int m = 0; m < 4; ++m) _Pragma("unroll") for (int n = 0; n < 2; ++n) _Pragma("unroll") for (int k = 0; k < 2; ++k) \
        acc[ai][bj][m][n] = __builtin_amdgcn_mfma_f32_16x16x32_bf16(Bt[n][k], At[m][k], acc[ai][bj][m][n], 0, 0, 0); __builtin_amdgcn_s_setprio(0); } while (0)
#define PG8_WAIT_V(n) asm volatile("s_waitcnt vmcnt(" #n ")" ::: "memory")
#define PG8_WAIT_L(n) asm volatile("s_waitcnt lgkmcnt(" #n ")" ::: "memory")
#define PG8_BAR __builtin_amdgcn_s_barrier()
#define PG8_SCHED __builtin_amdgcn_sched_barrier(0)
    Unit cur, nxt; int ui = 0;
    if (!S.next(0, cur)) return;
    f32x4 acc[2][2][4][2];
#pragma unroll
    for (int a = 0; a < 2; ++a)
#pragma unroll
        for (int b = 0; b < 2; ++b)
#pragma unroll
            for (int m = 0; m < 4; ++m)
#pragma unroll
                for (int n = 0; n < 2; ++n) acc[a][b][m][n] = (f32x4){0.f, 0.f, 0.f, 0.f};
    bf16x8 At[4][2], B0[2][2], B1[2][2];
    const char* cA = PG8_APTR(cur.pm); const char* cB = (const char*)g.Bt + (size_t)cur.pn * tstep;
    S.a_ready(cur);
    if constexpr (SP2) {
        PG8_STAGE(PG8_SB(0, 0), cB, voffB); PG8_STAGE(PG8_SB(0, 1), cB + hstep, voffB); PG8_STAGE(PG8_SA(0, 0), cA, voffA); PG8_STAGE(PG8_SA(0, 1), cA + hstepA, voffA);
        if (wr == 1) PG8_BAR;
        PG8_WAIT_V(2); PG8_BAR;
        PG8_STAGE(PG8_SB(1, 0), cB + kstep, voffB); PG8_STAGE(PG8_SA(1, 0), cA + kstep, voffA); PG8_STAGE(PG8_SB(1, 1), cB + hstep + kstep, voffB);
        PG8_WAIT_V(6); PG8_BAR;
    } else {
        PG8_STAGE(PG8_SB(0, 0), cB, voffB); PG8_STAGE(PG8_SA(0, 0), cA, voffA); PG8_STAGE(PG8_SB(0, 1), cB + hstep, voffB); PG8_STAGE(PG8_SA(0, 1), cA + hstepA, voffA);
        if (wr == 1) PG8_BAR;
        PG8_WAIT_V(4); PG8_BAR;
        PG8_STAGE(PG8_SB(1, 0), cB + kstep, voffB); PG8_STAGE(PG8_SA(1, 0), cA + kstep, voffA); PG8_STAGE(PG8_SB(1, 1), cB + hstep + kstep, voffB);
        PG8_WAIT_V(6); PG8_BAR;
    }
    for (;;) {
        const bool has_next = S.next(ui + 1, nxt);
        const char* nA = has_next ? PG8_APTR(nxt.pm) : cA; const char* nB = has_next ? (const char*)g.Bt + (size_t)nxt.pn * tstep : cB;
        for (int t = 0; t < nt; t += 2) {
            const bool last = (t == nt - 2);
            const char* a1 = cA + PG8_KOFFA(t + 1);
            const char* a2 = last ? nA : cA + PG8_KOFFA(t + 2); const char* b2 = last ? nB : cB + (size_t)(t + 2) * kstep;
            const char* a3 = a2 + kstep; const char* b3 = b2 + kstep;
            if (last && has_next) S.a_ready(nxt);
            if constexpr (SP2) {
            PG8_LDB(B0, 0, 0); PG8_LDB(B1, 0, 1); PG8_SCHED; PG8_LDA(At, 0, 0); PG8_STAGE(PG8_SA(1, 1), a1 + hstepA, voffA);
            PG8_WAIT_V(8); PG8_WAIT_L(0); PG8_BAR; PG8_MMA(0, 0, At, B0); PG8_MMA(0, 1, At, B1); PG8_BAR; PG8_SCHED;
            PG8_LDA(At, 0, 1); PG8_STAGE(PG8_SB(0, 0), b2, voffB); PG8_STAGE(PG8_SB(0, 1), b2 + hstep, voffB); PG8_STAGE(PG8_SA(0, 0), a2, voffA);
            PG8_WAIT_V(8); PG8_WAIT_L(0); PG8_BAR; PG8_MMA(1, 0, At, B0); PG8_MMA(1, 1, At, B1); PG8_BAR; PG8_SCHED;
            PG8_LDB(B0, 1, 0); PG8_LDB(B1, 1, 1); PG8_SCHED; PG8_LDA(At, 1, 0); PG8_STAGE(PG8_SA(0, 1), a2 + hstepA, voffA);
            PG8_WAIT_V(8); PG8_WAIT_L(0); PG8_BAR; PG8_MMA(0, 0, At, B0); PG8_MMA(0, 1, At, B1); PG8_BAR; PG8_SCHED;
            PG8_LDA(At, 1, 1); PG8_STAGE(PG8_SB(1, 0), b3, voffB); PG8_STAGE(PG8_SB(1, 1), b3 + hstep, voffB); PG8_STAGE(PG8_SA(1, 0), a3, voffA);
            PG8_WAIT_V(8); PG8_WAIT_L(0); PG8_BAR; PG8_MMA(1, 0, At, B0); PG8_MMA(1, 1, At, B1); PG8_BAR; PG8_SCHED;
            } else {
            PG8_LDB(B0, 0, 0); PG8_SCHED; PG8_LDA(At, 0, 0); PG8_STAGE(PG8_SA(1, 1), a1 + hstepA, voffA);
            PG8_WAIT_L(8); PG8_BAR; PG8_WAIT_L(0); PG8_MMA(0, 0, At, B0); PG8_BAR; PG8_SCHED;
            PG8_LDB(B1, 0, 1); PG8_STAGE(PG8_SB(0, 0), b2, voffB);
            PG8_BAR; PG8_WAIT_L(0); PG8_MMA(0, 1, At, B1); PG8_BAR;
            PG8_LDA(At, 0, 1); PG8_STAGE(PG8_SA(0, 0), a2, voffA);
            PG8_BAR; PG8_WAIT_L(0); PG8_MMA(1, 0, At, B0); PG8_BAR; PG8_SCHED;
            PG8_STAGE(PG8_SB(0, 1), b2 + hstep, voffB);
            PG8_WAIT_V(6); PG8_BAR; PG8_MMA(1, 1, At, B1); PG8_BAR;
            PG8_LDB(B0, 1, 0); PG8_SCHED; PG8_LDA(At, 1, 0); PG8_STAGE(PG8_SA(0, 1), a2 + hstepA, voffA);
            PG8_WAIT_L(8); PG8_BAR; PG8_WAIT_L(0); PG8_MMA(0, 0, At, B0); PG8_BAR; PG8_SCHED;
            PG8_LDB(B1, 1, 1); PG8_STAGE(PG8_SB(1, 0), b3, voffB);
            PG8_BAR; PG8_WAIT_L(0); PG8_MMA(0, 1, At, B1); PG8_BAR;
            PG8_LDA(At, 1, 1); PG8_STAGE(PG8_SA(1, 0), a3, voffA);
            PG8_BAR; PG8_WAIT_L(0); PG8_MMA(1, 0, At, B0); PG8_BAR; PG8_SCHED;
            PG8_STAGE(PG8_SB(1, 1), b3 + hstep, voffB);
            PG8_WAIT_V(6); PG8_BAR; PG8_MMA(1, 1, At, B1); PG8_BAR;
            }
        }
        if constexpr (ALIGN_EPI) { if (wr == 0) PG8_BAR; }
        if constexpr (!Epi::AFTER_DRAIN) { E(acc, cur, wr, wc, fr, fq); S.done(cur); }
        if (!has_next) break;
#pragma unroll
        for (int a = 0; a < 2; ++a)
#pragma unroll
            for (int b = 0; b < 2; ++b)
#pragma unroll
                for (int m = 0; m < 4; ++m)
#pragma unroll
                    for (int n = 0; n < 2; ++n) acc[a][b][m][n] = (f32x4){0.f, 0.f, 0.f, 0.f};
        cur = nxt; cA = nA; cB = nB; ++ui;
        if constexpr (ALIGN_EPI) { if (wr == 1) PG8_BAR; }
    }
    PG8_WAIT_V(0);
    if constexpr (!ALIGN_EPI) { if (wr == 0) PG8_BAR; }
    PG8_BAR;
    if constexpr (Epi::AFTER_DRAIN) { E.fused(acc, cur, wr, wc, fr, fq, lds, wid, lane); S.done(cur); }
#undef PG8_SA
#undef PG8_KOFFA
#undef PG8_APTR
#undef PG8_SB
#undef PG8_STAGE
#undef PG8_LDA
#undef PG8_LDB
#undef PG8_MMA
#undef PG8_WAIT_V
#undef PG8_WAIT_L
#undef PG8_BAR
#undef PG8_SCHED
}
}
#include <hip/hip_bf16.h>
#include <cmath>
namespace attn_body {
using bf16=__hip_bfloat16;
using bf16x8=__attribute__((ext_vector_type(8)))short;
using s16x4=__attribute__((ext_vector_type(4)))short;
using f32x16=__attribute__((ext_vector_type(16)))float;
using u32x4=__attribute__((ext_vector_type(4)))unsigned;
constexpr int BATCH=8,NHEAD=16,SEQ=4096,D=64,DM=NHEAD*D;
constexpr int NW=8,QBLK=32,QB=QBLK*NW,KVBLK=64,NQB=SEQ/QB;
constexpr int ATTN_PITCH=DM, ATTN_UNIT_ROWS=QB;
__device__ __forceinline__ int crow(int r,int hi){return (r&3)+8*(r>>2)+4*hi;}
#define SBAR() __builtin_amdgcn_sched_barrier(0)
__device__ __forceinline__ void cmask(f32x16&p0,f32x16&p1,int jb,int qrel,int hi){
  const float NEG=-INFINITY; int kb=64*jb+4*hi;
  #pragma unroll
  for(int r=0;r<16;++r){int kv=kb+(r&3)+8*(r>>2); if(kv>qrel)p0[r]=NEG; if(kv+32>qrel)p1[r]=NEG;}
}

constexpr int NSLOT=3, SLOTB=8192;
constexpr int LDS_K=0, LDS_V=NSLOT*SLOTB, LDS_WS=2*NSLOT*SLOTB, LDS_OST=LDS_WS+NW*64*4, LDS_BYTES=LDS_OST+NW*4096;
constexpr float C2=0.125f*1.4426950408889634f;
__device__ __forceinline__ void glds16(const void*gsrc,unsigned lds_dst){unsigned keep;
  asm volatile("s_mov_b32 %0, m0\n\ts_mov_b32 m0, %2\n\ts_nop 0\n\tglobal_load_lds_dwordx4 %1, off\n\ts_mov_b32 m0, %0":"=&s"(keep):"v"(gsrc),"s"(lds_dst):"memory");}
__device__ __forceinline__ float max3f(float a,float b,float c){float r;asm("v_max3_f32 %0, %1, %2, %3":"=v"(r):"v"(a),"v"(b),"v"(c));return r;}
__device__ __forceinline__ float max2f(float a,float b){float r;asm("v_max_f32_e32 %0, %1, %2":"=v"(r):"v"(a),"v"(b));return r;}
__device__ __forceinline__ float fadd_s(float a,float b){float r;asm("v_add_f32_e32 %0, %1, %2":"=v"(r):"v"(a),"v"(b));return r;}
__device__ __forceinline__ float fsub_s(float a,float b){float r;asm("v_sub_f32_e32 %0, %1, %2":"=v"(r):"v"(a),"v"(b));return r;}
typedef float f32x2_t __attribute__((ext_vector_type(2))); typedef __bf16 bf16x2_t __attribute__((ext_vector_type(2)));
__device__ __forceinline__ unsigned cvtpk_s(float lo,float hi){f32x2_t v={lo,hi};bf16x2_t b=__builtin_convertvector(v,bf16x2_t);return __builtin_bit_cast(unsigned,b);}
#define WAIT_BAR(N) asm volatile("s_waitcnt vmcnt(" #N ") lgkmcnt(0)\n\ts_barrier":::"memory")

__device__ __forceinline__ void qkt(f32x16&p0,f32x16&p1,const char*Kslot,const bf16x8*qr,const f32x16&negm,int r32,int hi){
  const char*kb=Kslot+hi*1024+r32*16;
  #pragma unroll
  for(int d0=0;d0<4;++d0){
    const bf16x8 b0=*reinterpret_cast<const bf16x8*>(kb+d0*2048);
    const bf16x8 b1=*reinterpret_cast<const bf16x8*>(kb+d0*2048+512);
    if(d0==0){p0=__builtin_amdgcn_mfma_f32_32x32x16_bf16(b0,qr[0],negm,0,0,0);p1=__builtin_amdgcn_mfma_f32_32x32x16_bf16(b1,qr[0],negm,0,0,0);}
    else{p0=__builtin_amdgcn_mfma_f32_32x32x16_bf16(b0,qr[d0],p0,0,0,0);p1=__builtin_amdgcn_mfma_f32_32x32x16_bf16(b1,qr[d0],p1,0,0,0);}}
}
typedef __attribute__((address_space(3))) const char* lds_cptr;
typedef short v4i16_t __attribute__((ext_vector_type(4)));
__device__ __forceinline__ void kload8(bf16x8*kf,lds_cptr kp){
  kf[0]=*(const __attribute__((address_space(3))) bf16x8*)(kp);      kf[1]=*(const __attribute__((address_space(3))) bf16x8*)(kp+512);
  kf[2]=*(const __attribute__((address_space(3))) bf16x8*)(kp+2048); kf[3]=*(const __attribute__((address_space(3))) bf16x8*)(kp+2560);
  kf[4]=*(const __attribute__((address_space(3))) bf16x8*)(kp+4096); kf[5]=*(const __attribute__((address_space(3))) bf16x8*)(kp+4608);
  kf[6]=*(const __attribute__((address_space(3))) bf16x8*)(kp+6144); kf[7]=*(const __attribute__((address_space(3))) bf16x8*)(kp+6656);
}
__device__ __forceinline__ void kload2(bf16x8*kf,lds_cptr kp,int j){ kf[2*j]=*(const __attribute__((address_space(3))) bf16x8*)(kp+j*2048); kf[2*j+1]=*(const __attribute__((address_space(3))) bf16x8*)(kp+j*2048+512); }
__device__ __forceinline__ s16x4 vtr(lds_cptr p){ return __builtin_bit_cast(s16x4,__builtin_amdgcn_ds_read_tr16_b64_v4i16((__attribute__((address_space(3))) v4i16_t*)p)); }
__device__ __forceinline__ float rowmax(const f32x16&p0,const f32x16&p1){
  float a=max3f(p0[0],p0[1],p1[0]),b=max3f(p0[2],p0[3],p1[1]);a=max3f(a,p1[2],p1[3]);
  #pragma unroll
  for(int r=4;r<16;r+=4){a=max3f(a,p0[r],p0[r+1]);b=max3f(b,p0[r+2],p0[r+3]);a=max3f(a,p1[r],p1[r+1]);b=max3f(b,p1[r+2],p1[r+3]);}
  const float m=max2f(a,b);
  auto rr=__builtin_amdgcn_permlane32_swap(__float_as_uint(m),__float_as_uint(m),false,false);
  return max2f(__uint_as_float(rr[0]),__uint_as_float(rr[1]));
}
__device__ __forceinline__ void pv(f32x16*o,int vb,bf16x8 pa0,bf16x8 pa1,bf16x8 pa2,bf16x8 pa3){
  #pragma unroll
  for(int d0=0;d0<2;++d0){s16x4 lo[4],hi[4];
    #pragma unroll
    for(int ks=0;ks<4;++ks){
      asm volatile("ds_read_b64_tr_b16 %0,%1 offset:%c2":"=&v"(lo[ks]):"v"(vb),"i"(d0*4096+ks*1024):"memory");
      asm volatile("ds_read_b64_tr_b16 %0,%1 offset:%c2":"=&v"(hi[ks]):"v"(vb),"i"(d0*4096+ks*1024+512):"memory");}
    asm volatile("s_waitcnt lgkmcnt(0)":::"memory");SBAR();
    #define PK(k) (bf16x8){lo[k][0],lo[k][1],lo[k][2],lo[k][3],hi[k][0],hi[k][1],hi[k][2],hi[k][3]}
    o[d0]=__builtin_amdgcn_mfma_f32_32x32x16_bf16(pa0,PK(0),o[d0],0,0,0);
    o[d0]=__builtin_amdgcn_mfma_f32_32x32x16_bf16(pa1,PK(1),o[d0],0,0,0);
    o[d0]=__builtin_amdgcn_mfma_f32_32x32x16_bf16(pa2,PK(2),o[d0],0,0,0);
    o[d0]=__builtin_amdgcn_mfma_f32_32x32x16_bf16(pa3,PK(3),o[d0],0,0,0);
    #undef PK
  }
}

#ifndef ATTN_STORE16
#define ATTN_STORE16(p,v) (*(u32x4*)(p)=(v))
#endif
template<int THRL> __device__ __forceinline__ void attn_unit(int b,int cq,int cv,int qb,const bf16*Q,const bf16*__restrict__ K,const bf16*__restrict__ V,bf16*O,char*shm){
  int tid_o_=threadIdx.x; asm volatile("":"+v"(tid_o_)); const int tid=tid_o_,lane=tid&63,r32=lane&31,hi=lane>>5; const int wid=__builtin_amdgcn_readfirstlane(tid>>6);
  const long rowbase=(long)b*SEQ; const int q0=qb*QB;
  const bf16*Qw=Q+(rowbase+q0+wid*QBLK)*DM+cq;
  const bf16*Kh=K+rowbase*DM+cq,*Vh=V+rowbase*DM+cv;
  const unsigned lds0=(unsigned)(uintptr_t)shm;
  float*wsf=(float*)(shm+LDS_WS)+wid*64;
  const bf16*ksrc=Kh+(long)lane*DM+wid*8;
  const bf16*vsrc=Vh+(long)(16*(wid&3)+(lane>>2))*DM+(wid>>2)*32+(lane&3)*8;
  const unsigned kdst=lds0+LDS_K+wid*1024, vdst=lds0+LDS_V+wid*1024;
  #define DMA_K(t,slot) glds16(ksrc+(long)(t)*KVBLK*DM,(unsigned)__builtin_amdgcn_readfirstlane(kdst+(slot)))
  #define DMA_V(t,slot) glds16(vsrc+(long)(t)*KVBLK*DM,(unsigned)__builtin_amdgcn_readfirstlane(vdst+(slot)))
  const int vb0=(int)(lds0+LDS_V)+((lane>>4)&1)*32+(lane&3)*8+(4*hi+((lane&15)>>2))*64;
  const char*Kbase=shm+LDS_K; bf16x8 kf[8];
  const lds_cptr shm3=(lds_cptr)shm; const lds_cptr kp0=shm3+LDS_K+hi*1024+r32*16; const lds_cptr vp0=shm3+LDS_V+((lane>>4)&1)*32+(lane&3)*8+(4*hi+((lane&15)>>2))*64;
  const int NT=(q0+QB)/KVBLK;
  DMA_K(0,0);DMA_V(0,0);DMA_K(1,SLOTB);
  bf16x8 qr[4];
  #pragma unroll
  for(int d0=0;d0<4;++d0)qr[d0]=*reinterpret_cast<const bf16x8*>(&Qw[(long)r32*DM+d0*16+hi*8]);
  float mhat=0.f,l_reg=0.f;f32x16 o[2];o[0]=f32x16{};o[1]=f32x16{};f32x16 negm=f32x16{};asm volatile("":"+v"(negm));
  const int qrel=wid*QBLK+r32;
  #define CMASK(P0,P1,t) do{int jb_=(t)-(NT-4); if(jb_>=0)cmask(P0,P1,jb_,qrel,hi);}while(0)
  bool resc=false;
  #define START(P0,P1) do{ const float rm=rowmax(P0,P1); resc=false; \
    { const float dl=rm; mhat=fadd_s(mhat,dl); \
      _Pragma("unroll") for(int r=0;r<16;++r){P0[r]=fsub_s(P0[r],dl);P1[r]=fsub_s(P1[r],dl);} \
      _Pragma("unroll") for(int r=0;r<16;++r)negm[r]=-mhat; asm volatile("":"+v"(negm)); } \
    _Pragma("unroll") for(int r=0;r<16;++r)P0[r]=__builtin_amdgcn_exp2f(P0[r]); }while(0)
  #define RESC() do{ if(resc){ asm volatile("s_waitcnt lgkmcnt(0)":::"memory"); \
      _Pragma("unroll") for(int d_=0;d_<2;++d_) _Pragma("unroll") for(int r=0;r<16;++r)o[d_][r]*=wsf[crow(r,hi)]; } }while(0)
  f32x16 pA0,pA1,pB0,pB1;
  int sl_prev=0,sl_cur=0,sl_next=SLOTB;
  #define ROT() do{sl_prev=sl_cur;sl_cur=sl_next;sl_next=(sl_next==(NSLOT-1)*SLOTB)?0:sl_next+SLOTB;}while(0)
  DMA_K(2,2*SLOTB);
  WAIT_BAR(3);
  qkt(pA0,pA1,Kbase,qr,negm,r32,hi);asm volatile("s_nop 15\n\ts_nop 7":"+v"(pA0),"+v"(pA1));CMASK(pA0,pA1,0);
  START(pA0,pA1);
  _Pragma("unroll") for(int r=0;r<16;++r)pA1[r]=__builtin_amdgcn_exp2f(pA1[r]);
  WAIT_BAR(0);
  DMA_K(3,0);DMA_V(1,SLOTB);
  ROT();
  kload8(kf,kp0+sl_cur);
  WAIT_BAR(2);
  s16x4 vlo[8],vhi[8]; u32x4 pw0,pw1,pw2,pw3;
  #define PKW(P,B) cvtpk_s(P[B],P[B+1])
  #define PAF(k) __builtin_bit_cast(bf16x8,pw##k)
  #define VFR(i) (bf16x8){vlo[i][0],vlo[i][1],vlo[i][2],vlo[i][3],vhi[i][0],vhi[i][1],vhi[i][2],vhi[i][3]}
  #define PIN(x) asm volatile("":"+v"(x))
  #define MX3(a,b,c) __builtin_fmaxf(__builtin_fmaxf((a),(b)),(c))
  #define GAPA(MF,A0,A1,A2,A3,W0,W1,PW) do{ MF; sacc+=A0; sacc+=A1; sacc+=A2; sacc+=A3; PIN(sacc); W0; W1; PIN(PW); SBAR(); }while(0)
  #define EX(v) __builtin_amdgcn_exp2f(v)
  #define GAPB(MF,X,B) do{ MF; X[B]=EX(X[B]); X[B+1]=EX(X[B+1]); X[B+2]=EX(X[B+2]); X[B+3]=EX(X[B+3]); PIN(X); SBAR(); }while(0)
  #define VRD(i) do{ vlo[i]=vtr(vp_+(((i)>>2)*4096+((i)&3)*1024)); vhi[i]=vtr(vp_+(((i)>>2)*4096+((i)&3)*1024+512)); }while(0)
  #define KRD(G,j) do{ if(G){ kload2(kf,kp0+sl_next,j); SBAR(); } }while(0)
  #define STEP(C0,C1,P0,P1,t,GK,GV,GL) do{ SBAR(); \
    const lds_cptr vp_=vp0+sl_prev; \
    VRD(0); SBAR(); float sacc=(P0[0]+P0[1]); \
    GAPA(C0=__builtin_amdgcn_mfma_f32_32x32x16_bf16(kf[0],qr[0],negm,0,0,0), P0[2],P0[3],P0[4],P0[5],     pw0[0]=PKW(P0,0), pw0[1]=PKW(P0,2), pw0); \
    VRD(4); SBAR(); GAPA(C1=__builtin_amdgcn_mfma_f32_32x32x16_bf16(kf[1],qr[0],negm,0,0,0), P0[6],P0[7],P0[8],P0[9],     pw0[2]=PKW(P0,4), pw0[3]=PKW(P0,6), pw0); \
    VRD(1); SBAR(); GAPA(C0=__builtin_amdgcn_mfma_f32_32x32x16_bf16(kf[2],qr[1],C0,0,0,0),   P0[10],P0[11],P0[12],P0[13], pw1[0]=PKW(P0,8), pw1[1]=PKW(P0,10), pw1); \
    VRD(5); SBAR(); GAPA(C1=__builtin_amdgcn_mfma_f32_32x32x16_bf16(kf[3],qr[1],C1,0,0,0),   P0[14],P0[15],P1[0],P1[1],   pw1[2]=PKW(P0,12),pw1[3]=PKW(P0,14), pw1); \
    VRD(2); SBAR(); GAPA(C0=__builtin_amdgcn_mfma_f32_32x32x16_bf16(kf[4],qr[2],C0,0,0,0),   P1[2],P1[3],P1[4],P1[5],     pw2[0]=PKW(P1,0), pw2[1]=PKW(P1,2), pw2); \
    VRD(6); SBAR(); GAPA(C1=__builtin_amdgcn_mfma_f32_32x32x16_bf16(kf[5],qr[2],C1,0,0,0),   P1[6],P1[7],P1[8],P1[9],     pw2[2]=PKW(P1,4), pw2[3]=PKW(P1,6), pw2); \
    VRD(3); SBAR(); GAPA(C0=__builtin_amdgcn_mfma_f32_32x32x16_bf16(kf[6],qr[3],C0,0,0,0),   P1[10],P1[11],P1[12],P1[13], pw3[0]=PKW(P1,8), pw3[1]=PKW(P1,10), pw3); \
    VRD(7); SBAR(); GAPA(C1=__builtin_amdgcn_mfma_f32_32x32x16_bf16(kf[7],qr[3],C1,0,0,0),   P1[14],P1[15],0.f,0.f,       pw3[2]=PKW(P1,12),pw3[3]=PKW(P1,14), pw3); \
    l_reg+=sacc; \
    if(GK){DMA_K((t)+3,sl_cur);} if(GV){DMA_V((t)+1,sl_next);} \
    CMASK(C0,C1,t); \
    { float a=MX3(C0[0],C0[1],C1[0]),b=MX3(C0[2],C0[3],C1[1]); a=MX3(a,C1[2],C1[3]); \
      _Pragma("unroll") for(int r=4;r<16;r+=4){a=MX3(a,C0[r],C0[r+1]);b=MX3(b,C0[r+2],C0[r+3]);a=MX3(a,C1[r],C1[r+1]);b=MX3(b,C1[r+2],C1[r+3]);} \
      float rm=__builtin_fmaxf(a,b); { auto rr=__builtin_amdgcn_permlane32_swap(__float_as_uint(rm),__float_as_uint(rm),false,false); rm=__builtin_fmaxf(__uint_as_float(rr[0]),__uint_as_float(rr[1])); } \
      resc=false; \
      if(__builtin_expect(__any(rm>(float)THRL),0)){ const float dl=__builtin_fmaxf(rm,0.f); mhat+=dl; \
        _Pragma("unroll") for(int r=0;r<16;++r){C0[r]-=dl;C1[r]-=dl;} \
        _Pragma("unroll") for(int r=0;r<16;++r)negm[r]=-mhat; asm volatile("":"+v"(negm)); \
        const float f=__builtin_amdgcn_exp2f(-dl); l_reg*=f; if(hi==0)wsf[r32]=f; resc=true; } } \
    SBAR(); \
    GAPB(o[0]=__builtin_amdgcn_mfma_f32_32x32x16_bf16(PAF(0),VFR(0),o[0],0,0,0), C0,0); \
    GAPB(o[1]=__builtin_amdgcn_mfma_f32_32x32x16_bf16(PAF(0),VFR(4),o[1],0,0,0), C0,4); \
    KRD(GL,0); GAPB(o[0]=__builtin_amdgcn_mfma_f32_32x32x16_bf16(PAF(1),VFR(1),o[0],0,0,0), C0,8); \
    KRD(GL,1); GAPB(o[1]=__builtin_amdgcn_mfma_f32_32x32x16_bf16(PAF(1),VFR(5),o[1],0,0,0), C0,12); \
    KRD(GL,2); GAPB(o[0]=__builtin_amdgcn_mfma_f32_32x32x16_bf16(PAF(2),VFR(2),o[0],0,0,0), C1,0); \
    KRD(GL,3); GAPB(o[1]=__builtin_amdgcn_mfma_f32_32x32x16_bf16(PAF(2),VFR(6),o[1],0,0,0), C1,4); \
    GAPB(o[0]=__builtin_amdgcn_mfma_f32_32x32x16_bf16(PAF(3),VFR(3),o[0],0,0,0), C1,8); \
    GAPB(o[1]=__builtin_amdgcn_mfma_f32_32x32x16_bf16(PAF(3),VFR(7),o[1],0,0,0), C1,12); \
    }while(0)
  int t=1;
  #undef CMASK
  #define CMASK(P0,P1,t) do{}while(0)
  for(;t+5<NT;t+=2){
    STEP(pB0,pB1,pA0,pA1,t,true,true,true);     WAIT_BAR(2); RESC(); ROT();
    STEP(pA0,pA1,pB0,pB1,t+1,true,true,true);   WAIT_BAR(2); RESC(); ROT();
  }
  #undef CMASK
  #define CMASK(P0,P1,t) do{int jb_=(t)-(NT-4); if(jb_>=0)cmask(P0,P1,jb_,qrel,hi);}while(0)
  #define ENDW(tt) do{ if((tt)+3<NT){WAIT_BAR(2);} else if((tt)+2<NT){WAIT_BAR(1);} else {WAIT_BAR(0);} }while(0)
  for(;t+1<NT;t+=2){
    STEP(pB0,pB1,pA0,pA1,t,(t+3<NT),(t+1<NT),(t+1<NT));       ENDW(t);   RESC(); ROT();
    STEP(pA0,pA1,pB0,pB1,t+1,(t+4<NT),(t+2<NT),(t+2<NT));     ENDW(t+1); RESC(); ROT();
  }
  STEP(pB0,pB1,pA0,pA1,NT-1,false,false,false); RESC();
  { float sacc=pB0[0]+pB0[1]; _Pragma("unroll") for(int r=2;r<16;++r)sacc+=pB0[r]; _Pragma("unroll") for(int r=0;r<16;++r)sacc+=pB1[r]; l_reg+=sacc;
    pw0=(u32x4){PKW(pB0,0),PKW(pB0,2),PKW(pB0,4),PKW(pB0,6)};pw1=(u32x4){PKW(pB0,8),PKW(pB0,10),PKW(pB0,12),PKW(pB0,14)};pw2=(u32x4){PKW(pB1,0),PKW(pB1,2),PKW(pB1,4),PKW(pB1,6)};pw3=(u32x4){PKW(pB1,8),PKW(pB1,10),PKW(pB1,12),PKW(pB1,14)};
    SBAR(); pv(o,vb0+sl_cur,PAF(0),PAF(1),PAF(2),PAF(3)); }
  #undef PKW
  #undef PAF
  #undef VFR
  #undef PIN
  #undef MX3
  #undef GAPA
  #undef GAPB
  #undef EX
  #undef VRD
  #undef KRD
  #undef STEP
  #undef ENDW
  {auto rr=__builtin_amdgcn_permlane32_swap(__float_as_uint(l_reg),__float_as_uint(l_reg),false,false);l_reg=__uint_as_float(rr[0])+__uint_as_float(rr[1]);}
  if(hi==0)wsf[32+r32]=l_reg;asm volatile("s_waitcnt lgkmcnt(0)":::"memory");
  float rli[16];
  #pragma unroll
  for(int r=0;r<16;++r)rli[r]=__builtin_amdgcn_rcpf(wsf[32+crow(r,hi)]);
  bf16*Ow=O+(rowbase+q0+wid*QBLK)*DM+cv;
  { bf16*stg=(bf16*)(shm+LDS_OST)+wid*2048;
    #pragma unroll
    for(int r=0;r<16;++r){const int orow=crow(r,hi);
      #pragma unroll
      for(int d0=0;d0<2;++d0)stg[orow*64+d0*32+r32]=__float2bfloat16(o[d0][r]*rli[r]);}
    asm volatile("s_waitcnt lgkmcnt(0)":::"memory");
    #pragma unroll
    for(int i=0;i<4;++i){const int row=i*8+(lane>>3),ch=lane&7; const u32x4 v=*(const u32x4*)(stg+row*64+ch*8); ATTN_STORE16(Ow+(long)row*DM+ch*8,v);} }
  asm volatile("s_waitcnt lgkmcnt(0)\n\ts_barrier":::"memory");
  #undef DMA_K
  #undef DMA_V
  #undef CMASK
  #undef START
  #undef RESC
  #undef ROT
}
constexpr int ATTN_LDS_BYTES=LDS_BYTES;
#undef SBAR
#undef WAIT_BAR
}
#define LAS __attribute__((address_space(3)))
using pg8::bf16_t; using pg8::f32x4; using pg8::u32x4; using pg8::bf16x8; using pg8::cvt_pk_bf16; using pg8::f32x2;
typedef unsigned u32x2 __attribute__((ext_vector_type(2)));
constexpr int NB = 8, S = 4096, D = 1024, T = NB * S, FF = 2816, FF2 = 5632, SP = S + 8;
constexpr int NWAVES = 8, NTHR = 512;
constexpr size_t MiB = 1u << 20;
constexpr size_t WS_W = 0, WS_H = 112 * MiB, WS_A = 177 * MiB;
constexpr size_t WS_VF = WS_A, WS_L = WS_A + 64 * MiB, WS_R = WS_A + 96 * MiB, WS_K = WS_A + 160 * MiB, WS_V1 = WS_A + 224 * MiB;
constexpr size_t WS_ACT_R = WS_R;
constexpr size_t WS_KS = WS_A, WS_VS = WS_A + 64 * MiB, WS_Q = WS_A + 128 * MiB, WS_O0 = WS_A + 192 * MiB, WS_O1 = WS_A + 256 * MiB;
constexpr size_t WS_HK = WS_O0, WS_ACT_B = WS_Q;
constexpr size_t WS_MOD = 497 * MiB, WS_ROPE = 498 * MiB, WS_CTL = 499 * MiB, WS_END = 500 * MiB, WS_MODP = WS_R;
constexpr size_t WS_SS = WS_CTL + 131072;
constexpr size_t WS_BIASUP = WS_ROPE + 262144;
constexpr size_t WS_BIASQ = WS_MOD + 786432;
constexpr size_t WS_KVNC = WS_BIASQ + 65536;
static_assert((size_t)(NB * SP + 128) * D * 2 <= 65 * MiB, "H");
static_assert((size_t)T * FF * 2 <= 176 * MiB, "act");
constexpr size_t NRKVL = 3584;
constexpr size_t WE_RWKV = NRKVL * 2048 + (size_t)D * D + (size_t)D * 320;
constexpr size_t WE_FFN = (size_t)FF2 * D + (size_t)D * FF;
__host__ __device__ constexpr size_t we_rkvl(int l) { return (size_t)l * WE_RWKV; }
__host__ __device__ constexpr size_t we_woa(int l) { return we_rkvl(l) + NRKVL * 2048; }
__host__ __device__ constexpr size_t we_lb(int l) { return we_woa(l) + (size_t)D * D; }
__host__ __device__ constexpr size_t we_up(int l) { return 2 * WE_RWKV + (size_t)l * WE_FFN; }
__host__ __device__ constexpr size_t we_dn(int l) { return we_up(l) + (size_t)FF2 * D; }
constexpr size_t WE_KV = 2 * WE_RWKV + 4 * WE_FFN;
__host__ __device__ constexpr size_t we_q(int j) { return WE_KV + (size_t)2 * D * D + (size_t)j * D * D; }
__host__ __device__ constexpr size_t we_ob(int j) { return WE_KV + (size_t)4 * D * D + (size_t)j * D * D; }
static_assert((WE_KV + (size_t)6 * D * D) * 2 <= 112 * MiB, "weights");
constexpr int LDS_BYTES = 147456;

__device__ __forceinline__ float bf2f(unsigned short h) { return __uint_as_float((unsigned)h << 16); }

template <int CTRL> __device__ __forceinline__ float dppf(float v) { return __int_as_float(__builtin_amdgcn_update_dpp(0, __float_as_int(v), CTRL, 0xf, 0xf, true)); }
__device__ __forceinline__ float sigm(float x) { return __builtin_amdgcn_rcpf(1.f + __expf(-x)); }
__device__ __forceinline__ float row16_sum(float v) { v += dppf<0xB1>(v); v += dppf<0x4E>(v); v += dppf<0x141>(v); v += dppf<0x140>(v); return v; }
__device__ __forceinline__ float row8_sum(float v) { v += dppf<0xB1>(v); v += dppf<0x4E>(v); v += dppf<0x141>(v); return v; }
__device__ __forceinline__ float xlane16(float v) { return v + __int_as_float(__builtin_amdgcn_ds_swizzle(__float_as_int(v), 0x401F)); }
__device__ __forceinline__ float xlane32(float v) { auto rr = __builtin_amdgcn_permlane32_swap(__float_as_uint(v), __float_as_uint(v), false, false); return __uint_as_float(rr[0]) + __uint_as_float(rr[1]); }
__device__ __forceinline__ float wave_sum_dpp(float v) {
    v = row16_sum(v);
    return __int_as_float(__builtin_amdgcn_readlane(__float_as_int(v), 0)) + __int_as_float(__builtin_amdgcn_readlane(__float_as_int(v), 16)) +
           __int_as_float(__builtin_amdgcn_readlane(__float_as_int(v), 32)) + __int_as_float(__builtin_amdgcn_readlane(__float_as_int(v), 48));
}
__device__ __forceinline__ float wave_sum(float v) { return wave_sum_dpp(v); }
#define BAR_LDS() asm volatile("s_waitcnt lgkmcnt(0)\n\ts_barrier" ::: "memory")

#define GAS __attribute__((address_space(1)))
#define GLD4(p, boff) (*(const GAS f32x4*)((const GAS char*)(p) + (unsigned)(boff)))
struct EpiRkvL {
    static constexpr bool PERM = true, AFTER_DRAIN = false;
    bf16_t *R, *K, *V, *L;
    __device__ __forceinline__ void operator()(const f32x4 (&acc)[2][2][4][2], const pg8::Unit& u, int wr, int wc, int fr, int fq) const {
        { int t_ = threadIdx.x; asm volatile("" : "+v"(t_)); fr = t_ & 15; fq = (t_ >> 4) & 3; }
        const int pn = u.pn; const int ldc = pn < 12 ? D : 512, colt = pn < 12 ? (pn & 3) * 256 : (pn - 12) * 256;
        unsigned long long bp = (unsigned long long)(uintptr_t)L;
        if (pn < 12) bp = (unsigned long long)(uintptr_t)V;
        asm volatile("" : "+s"(bp));
        if (pn < 8) bp = (unsigned long long)(uintptr_t)K;
        asm volatile("" : "+s"(bp));
        if (pn < 4) bp = (unsigned long long)(uintptr_t)R;
        GAS char* base = (GAS char*)(uintptr_t)bp;
        const int row0 = u.pm * 256 + wr * 64 + fr, col0 = colt + wc * 32 + 8 * fq;
#pragma unroll
        for (int ai = 0; ai < 2; ++ai)
#pragma unroll
            for (int m = 0; m < 4; ++m) { const unsigned off = ((unsigned)(row0 + ai * 128 + m * 16) * (unsigned)ldc + (unsigned)col0) * 2u;
#pragma unroll
                for (int bj = 0; bj < 2; ++bj) { f32x4 v0 = acc[ai][bj][m][0], v1 = acc[ai][bj][m][1];
                    if (pn >= 12) {
                        const int c0 = col0 + bj * 128;
                        const int ty = c0 < 64 ? 1 : ((c0 >= 160 && c0 < 320) ? 2 : 0);
                        if (ty) { const float A = ty == 1 ? 2.f : 1.f, C = ty == 1 ? -1.f : 0.f;
#pragma unroll
                            for (int e = 0; e < 4; ++e) { v0[e] = A * sigm(A * v0[e]) + C; v1[e] = A * sigm(A * v1[e]) + C; } } }
                    u32x4 w; w.x = cvt_pk_bf16(v0[0], v0[1]); w.y = cvt_pk_bf16(v0[2], v0[3]); w.z = cvt_pk_bf16(v1[0], v1[1]); w.w = cvt_pk_bf16(v1[2], v1[3]);
                    *(GAS u32x4*)(base + off + bj * 256) = w; } }
    }
};
struct EpiRes {
    static constexpr bool PERM = false, AFTER_DRAIN = false;
    const float* base; float* out; unsigned char* wsb; const float* nwn; unsigned gate_off, sc_off, ss_off; int next;
    __device__ __forceinline__ void operator()(const f32x4 (&acc)[2][2][4][2], const pg8::Unit& u, int wr, int wc, int fr, int fq) const {
        { int t_ = threadIdx.x; asm volatile("" : "+v"(t_)); fr = t_ & 15; fq = (t_ >> 4) & 3; }
        const int b = u.pm >> 4, col0 = u.pn * 256 + wc * 32 + 4 * fq;
        f32x4 gv[2][2], gm[2][2];
#pragma unroll
        for (int bj = 0; bj < 2; ++bj)
#pragma unroll
            for (int n = 0; n < 2; ++n) { gv[bj][n] = GLD4(wsb, gate_off + (b * 6144 + col0 + bj * 128 + n * 16) * 4);
                gm[bj][n] = next ? GLD4(nwn, (col0 + bj * 128 + n * 16) * 4) * (GLD4(wsb, sc_off + (b * 6144 + col0 + bj * 128 + n * 16) * 4) + 1.f) : gv[bj][n]; }
#pragma unroll
        for (int ai = 0; ai < 2; ++ai) {
            f32x4 bsa[4][2][2];
#pragma unroll
            for (int m = 0; m < 4; ++m) { const unsigned off = ((unsigned)(u.pm * 256 + ai * 128 + wr * 64 + m * 16 + fr) * (unsigned)D + (unsigned)col0) * 4u;
#pragma unroll
                for (int bj = 0; bj < 2; ++bj)
#pragma unroll
                    for (int n = 0; n < 2; ++n) bsa[m][bj][n] = GLD4(base, off + bj * 512 + n * 64); }
#pragma unroll
            for (int m = 0; m < 4; ++m) { const int row = u.pm * 256 + ai * 128 + wr * 64 + m * 16 + fr; const unsigned off = ((unsigned)row * (unsigned)D + (unsigned)col0) * 4u;
                f32x4 bs[2][2];
#pragma unroll
                for (int bj = 0; bj < 2; ++bj)
#pragma unroll
                    for (int n = 0; n < 2; ++n) { bs[bj][n] = bsa[m][bj][n] + gv[bj][n] * acc[ai][bj][m][n]; *(GAS f32x4*)((GAS char*)out + (off + bj * 512 + n * 64)) = bs[bj][n]; }
                if (next) { float sq = 0.f; const unsigned hoff = (unsigned)WS_H + ((unsigned)(b * SP + 8 + (row & (S - 1))) * (unsigned)D + (unsigned)col0) * 2u;
#pragma unroll
                    for (int bj = 0; bj < 2; ++bj)
#pragma unroll
                        for (int n = 0; n < 2; ++n) { const f32x4 x = bs[bj][n]; sq += (x[0] * x[0] + x[1] * x[1]) + (x[2] * x[2] + x[3] * x[3]); const f32x4 h = x * gm[bj][n];
                            u32x2 w; w.x = cvt_pk_bf16(h[0], h[1]); w.y = cvt_pk_bf16(h[2], h[3]); *(GAS u32x2*)((GAS char*)wsb + (hoff + bj * 256 + n * 32)) = w;
                            if (next == 2) { const f32x4 k = x * GLD4(wsb, (unsigned)WS_KVNC + (col0 + bj * 128 + n * 16) * 4); u32x2 w2; w2.x = cvt_pk_bf16(k[0], k[1]); w2.y = cvt_pk_bf16(k[2], k[3]);
                                *(GAS u32x2*)((GAS char*)wsb + ((unsigned)(WS_HK - WS_H) + hoff + bj * 256 + n * 32)) = w2; } }
                    sq = xlane32(xlane16(sq));
                    if (fq == 0) (void)__builtin_amdgcn_global_atomic_fadd_f32((GAS float*)((GAS char*)wsb + ss_off) + row, sq); }
            }
        }
    }
};
struct EpiRope {
    static constexpr bool PERM = false, AFTER_DRAIN = false;
    unsigned char* wsb; unsigned oa_off, ob_off, ss_off, bias_off; float scale0; int defer, hasbias;
    __device__ __forceinline__ void operator()(const f32x4 (&acc)[2][2][4][2], const pg8::Unit& u, int wr, int wc, int fr, int fq) const {
        { int t_ = threadIdx.x; asm volatile("" : "+v"(t_)); fr = t_ & 15; fq = (t_ >> 4) & 3; }
        const bool ra = u.pn < 4; GAS char* O = (GAS char*)wsb + (ra ? oa_off : ob_off); const float sc = ra ? scale0 : 1.f;
        const int col0 = (u.pn & 3) * 256 + wc * 32 + 4 * fq; const bool dorope = ra && ((wc & 1) == 0) && fq < 2;
#pragma unroll
        for (int ai = 0; ai < 2; ++ai)
#pragma unroll
            for (int m = 0; m < 4; ++m) { const int row = u.pm * 256 + ai * 128 + wr * 64 + m * 16 + fr; const int t = row & (S - 1);
                const float rs = defer ? rsqrtf(*(const GAS float*)((const GAS char*)wsb + (ss_off + (unsigned)row * 4u)) * (1.f / D) + 1e-6f) : 1.f;
                f32x4 cs = {1.f, 1.f, 1.f, 1.f}, sn = {0.f, 0.f, 0.f, 0.f};
                if (dorope) { cs = GLD4(wsb, (unsigned)WS_ROPE + (t * 8 + 4 * fq) * 4); sn = GLD4(wsb, (unsigned)WS_ROPE + (S * 8 + t * 8 + 4 * fq) * 4); }
#pragma unroll
                for (int bj = 0; bj < 2; ++bj) { f32x4 x1 = acc[ai][bj][m][0] * rs, x2 = acc[ai][bj][m][1] * rs;
                    if (hasbias) { const unsigned bo = bias_off + (unsigned)((u.pm >> 4) * D + col0 + bj * 128) * 4u; x1 = x1 + GLD4(wsb, bo); x2 = x2 + GLD4(wsb, bo + 64); }
                    const f32x4 o1 = (x1 * cs - x2 * sn) * sc, o2 = (x2 * cs + x1 * sn) * sc;
                    u32x2 w1, w2; w1.x = cvt_pk_bf16(o1[0], o1[1]); w1.y = cvt_pk_bf16(o1[2], o1[3]); w2.x = cvt_pk_bf16(o2[0], o2[1]); w2.y = cvt_pk_bf16(o2[2], o2[3]);
                    const unsigned off = ((unsigned)row * (unsigned)D + (unsigned)(col0 + bj * 128)) * 2u; *(GAS u32x2*)(O + off) = w1; *(GAS u32x2*)(O + off + 32) = w2; } }
    }
};
struct EpiUp {
    static constexpr bool PERM = false, AFTER_DRAIN = false;
    unsigned char* wsb; const float* cw; const float* cb; unsigned act_off, ss_off, bias_off;
    __device__ __forceinline__ void operator()(const f32x4 (&acc)[2][2][4][2], const pg8::Unit& u, int wr, int wc, int fr, int fq) const {
        { int t_ = threadIdx.x; asm volatile("" : "+v"(t_)); fr = t_ & 15; fq = (t_ >> 4) & 3; }
        const int b = u.pm / 17, ui = u.pm % 17;
#pragma unroll
        for (int n = 0; n < 2; ++n) { const int ch0 = 128 * u.pn + 32 * wc + 16 * n + 4 * fq;
            const unsigned bo_ = bias_off + (unsigned)(b * FF2 + 256 * u.pn + 32 * wc + 16 * n + 4 * fq) * 4u;
#pragma unroll
            for (int ai = 0; ai < 2; ++ai) { const int tb = 248 * ui + 62 * (2 * ai + wr) - 2;
                float rs[4];
#pragma unroll
                for (int m = 0; m < 4; ++m) { const int t = tb + 16 * m + fr; const bool in = t >= 0 && t < S;
                    rs[m] = in ? rsqrtf(*(const GAS float*)((const GAS char*)wsb + (ss_off + (unsigned)(b * S + (in ? t : 0)) * 4u)) * (1.f / D) + 1e-6f) : 0.f; }
                const bool z0 = (tb + fr) < 0;
                f32x4 ug[4];
                { const f32x4 w0 = GLD4(cw, ch0 * 4), w1 = GLD4(cw, (FF2 + ch0) * 4), w2 = GLD4(cw, (2 * FF2 + ch0) * 4), bb = GLD4(cb, ch0 * 4), bu0 = GLD4(wsb, bo_);
                    f32x4 q1 = bb, q2 = bb;
#pragma unroll
                    for (int m = 0; m < 4; ++m) { f32x4 x = acc[ai][0][m][n] * rs[m] + bu0; if (m == 0 && z0) x = (f32x4){0.f, 0.f, 0.f, 0.f}; f32x4 r1, r2;
#pragma unroll
                        for (int j = 0; j < 4; ++j) { r1[j] = dppf<0x121>(x[j]); r2[j] = dppf<0x122>(x[j]); }
                        const f32x4 p1 = fr == 0 ? q1 : r1, p2 = fr < 2 ? q2 : r2; ug[m] = bb + w0 * p2 + w1 * p1 + w2 * x; q1 = r1; q2 = r2; } }
                { const int c = ch0 + FF; const f32x4 w0 = GLD4(cw, c * 4), w1 = GLD4(cw, (FF2 + c) * 4), w2 = GLD4(cw, (2 * FF2 + c) * 4), bb = GLD4(cb, c * 4), bu1 = GLD4(wsb, bo_ + 512);
                    f32x4 q1 = bb, q2 = bb;
#pragma unroll
                    for (int m = 0; m < 4; ++m) { f32x4 x = acc[ai][1][m][n] * rs[m] + bu1; if (m == 0 && z0) x = (f32x4){0.f, 0.f, 0.f, 0.f}; f32x4 r1, r2;
#pragma unroll
                        for (int j = 0; j < 4; ++j) { r1[j] = dppf<0x121>(x[j]); r2[j] = dppf<0x122>(x[j]); }
                        const f32x4 p1 = fr == 0 ? q1 : r1, p2 = fr < 2 ? q2 : r2; const f32x4 uv = bb + w0 * p2 + w1 * p1 + w2 * x; q1 = r1; q2 = r2;
                        const int rr = 16 * m + fr, t = tb + rr; const f32x4 g = ug[m]; f32x4 o;
#pragma unroll
                        for (int j = 0; j < 4; ++j) o[j] = g[j] * sigm(g[j]) * uv[j];
                        if (rr >= 2 && t < S) { u32x2 w; w.x = cvt_pk_bf16(o[0], o[1]); w.y = cvt_pk_bf16(o[2], o[3]); *(GAS u32x2*)((GAS char*)wsb + (act_off + ((unsigned)(b * S + t) * (unsigned)FF + (unsigned)ch0) * 2u)) = w; } } }
                __builtin_amdgcn_sched_barrier(0);
            } }
    }
};

struct Job { const float* W; const float* mu; bf16_t* Bt; int ldw, K, N, ldb, kdst0, mode, map, rowoff, start; };
__device__ __forceinline__ int colmap(int map, int n) {
    if (map == 1) { const int half = n >= FF ? 1 : 0, ch = n - half * FF; return 256 * (ch >> 7) + 128 * half + (ch & 127); }
    if (map == 2) { const int d = n & 63; const int p = (d >= 8 && d < 16) ? d + 8 : ((d >= 16 && d < 24) ? d - 8 : d); return (n & ~63) + p; }
    return n;
}
__device__ __forceinline__ void tr_load(const LAS Job* jb, int item, float (&v)[32], int lane) {
    const float* W = jb->W; const float* mu = jb->mu; const int ldw = jb->ldw, N = jb->N, mode = jb->mode;
    const int nblk = N / 32, kb = item / nblk, nb = item % nblk, k0 = 64 * kb, n0 = 32 * nb;
#pragma unroll
    for (int i = 0; i < 32; ++i) { const int kk = 2 * i + (lane >> 5); float x = W[(size_t)(k0 + kk) * ldw + n0 + (lane & 31)];
        if (mode) { const float m = mu[k0 + kk]; x *= (mode == 1) ? (1.f - m) : m; }
        v[i] = x; }
}
__device__ __forceinline__ void tr_store(const LAS Job* jb, int item, const float (&v)[32], LAS float* scr, int lane) {
    bf16_t* Bt = jb->Bt; const int N = jb->N, ldb = jb->ldb, kdst0 = jb->kdst0, map = jb->map, rowoff = jb->rowoff;
    const int nblk = N / 32, kb = item / nblk, nb = item % nblk, k0 = 64 * kb, n0 = 32 * nb;
#pragma unroll
    for (int i = 0; i < 32; ++i) scr[(2 * i + (lane >> 5)) * 33 + (lane & 31)] = v[i];
    asm volatile("s_waitcnt lgkmcnt(0)" ::: "memory");
    const int c = lane & 7;
#pragma unroll
    for (int j = 0; j < 4; ++j) { const int n = (lane >> 3) + 8 * j; const LAS float* s = scr + (8 * c) * 33 + n;
        u32x4 o; o.x = cvt_pk_bf16(s[0 * 33], s[1 * 33]); o.y = cvt_pk_bf16(s[2 * 33], s[3 * 33]); o.z = cvt_pk_bf16(s[4 * 33], s[5 * 33]); o.w = cvt_pk_bf16(s[6 * 33], s[7 * 33]);
        *(u32x4*)(Bt + (size_t)(rowoff + colmap(map, n0 + n)) * ldb + kdst0 + k0 + 8 * c) = o; }
    asm volatile("s_waitcnt lgkmcnt(0)" ::: "memory");
}
__device__ __forceinline__ float rope_inv(int i) {
    return i == 0 ? 1.0f : i == 1 ? 0.1939227432012558f : i == 2 ? 0.03760603070259094f : i == 3 ? 0.007292664609849453f : i == 4 ? 0.0014142135623842478f
         : i == 5 ? 0.00027424818836152554f : i == 6 ? 5.3182957344688475e-05f : 1.0313385246263351e-05f;
}

__device__ __forceinline__ void norm_phase(const float* x, const float* nw, const float* modl, int shoff, int scoff, bf16_t* H, const float* kvn, bf16_t* HK, int gw, int NGW, int lane) {
    for (int row = gw; row < T; row += NGW) {
        const int b = row >> 12, t = row & (S - 1);
        const f32x4* xr = (const f32x4*)(x + (size_t)row * D) + lane;
        f32x4 v[4]; float ss = 0.f;
#pragma unroll
        for (int j = 0; j < 4; ++j) { v[j] = xr[64 * j]; ss += (v[j].x * v[j].x + v[j].y * v[j].y) + (v[j].z * v[j].z + v[j].w * v[j].w); }
        const float rstd = rsqrtf(wave_sum(ss) * (1.f / D) + 1e-6f);
        const float* mb = modl + (size_t)b * 6144;
        const size_t orow = ((size_t)b * SP + 8 + t) * D;
#pragma unroll
        for (int j = 0; j < 4; ++j) { const int col = 4 * (lane + 64 * j);
            const f32x4 g = *(const f32x4*)(nw + col), sc = *(const f32x4*)(mb + scoff + col), sh = *(const f32x4*)(mb + shoff + col);
            const f32x4 y = v[j] * rstd * g; const f32x4 h = y * (sc + 1.f) + sh;
            u32x2 w; w.x = cvt_pk_bf16(h[0], h[1]); w.y = cvt_pk_bf16(h[2], h[3]); *(u32x2*)(H + orow + col) = w;
            if (HK) { const f32x4 k = v[j] * rstd * *(const f32x4*)(kvn + col); u32x2 w2; w2.x = cvt_pk_bf16(k[0], k[1]); w2.y = cvt_pk_bf16(k[2], k[3]); *(u32x2*)(HK + orow + col) = w2; } }
    }
}
__device__ __forceinline__ void final_norm_phase(float* x, const float* nw, int gw, int NGW, int lane) {
    for (int row = gw; row < T; row += NGW) {
        f32x4* xr = (f32x4*)(x + (size_t)row * D) + lane;
        f32x4 v[4]; float ss = 0.f;
#pragma unroll
        for (int j = 0; j < 4; ++j) { v[j] = xr[64 * j]; ss += (v[j].x * v[j].x + v[j].y * v[j].y) + (v[j].z * v[j].z + v[j].w * v[j].w); }
        const float rstd = rsqrtf(wave_sum(ss) * (1.f / D) + 1e-6f);
#pragma unroll
        for (int j = 0; j < 4; ++j) xr[64 * j] = v[j] * rstd * *(const f32x4*)(nw + 4 * (lane + 64 * j));
    }
}
__device__ __forceinline__ void combine_phase(bf16_t* O0, const bf16_t* O1, const float* lamv, const float* subln, float lam_init, int gw, int NGW, int lane) {
    const float d01 = wave_sum(lamv[lane] * lamv[64 + lane]), d23 = wave_sum(lamv[128 + lane] * lamv[192 + lane]);
    const float lam = __expf(d01) - __expf(d23) + lam_init, osc = 1.f - lam_init;
    float sw[16];
#pragma unroll
    for (int i = 0; i < 16; ++i) sw[i] = subln[(16 * lane + i) & 127] * osc;
    for (int row = gw; row < T; row += NGW) {
        bf16_t* p0 = O0 + (size_t)row * D + 16 * lane; const bf16_t* p1 = O1 + (size_t)row * D + 16 * lane;
        const u32x4 a0 = *(const u32x4*)p0, a1 = *(const u32x4*)(p0 + 8), b0 = *(const u32x4*)p1, b1 = *(const u32x4*)(p1 + 8);
        float o[16]; float ss = 0.f;
#pragma unroll
        for (int i = 0; i < 4; ++i) { const unsigned ua = a0[i], ub = b0[i], uc = a1[i], ud = b1[i];
            o[2 * i] = __uint_as_float(ua << 16) - lam * __uint_as_float(ub << 16); o[2 * i + 1] = __uint_as_float(ua & 0xffff0000u) - lam * __uint_as_float(ub & 0xffff0000u);
            o[8 + 2 * i] = __uint_as_float(uc << 16) - lam * __uint_as_float(ud << 16); o[8 + 2 * i + 1] = __uint_as_float(uc & 0xffff0000u) - lam * __uint_as_float(ud & 0xffff0000u); }
#pragma unroll
        for (int i = 0; i < 16; ++i) ss += o[i] * o[i];
        ss = row8_sum(ss);
        const float rstd = rsqrtf(ss * (1.f / 128.f) + 1e-6f);
        u32x4 w0, w1;
#pragma unroll
        for (int i = 0; i < 4; ++i) { w0[i] = cvt_pk_bf16(o[2 * i] * rstd * sw[2 * i], o[2 * i + 1] * rstd * sw[2 * i + 1]); w1[i] = cvt_pk_bf16(o[8 + 2 * i] * rstd * sw[8 + 2 * i], o[9 + 2 * i] * rstd * sw[9 + 2 * i]); }
        *(u32x4*)p0 = w0; *(u32x4*)(p0 + 8) = w1;
    }
}
struct ScanP { const bf16_t *R, *K, *V, *VF, *L; bf16_t* Y; const bf16_t* LB; const float *w0, *a0, *v0, *kk, *ka, *rk, *lnw, *lnb; int vres; };
__device__ __forceinline__ unsigned f2bf1(float f) { const unsigned u = __float_as_uint(f); return (u + 0x7fffu + ((u >> 16) & 1u)) >> 16; }
typedef __bf16 bf16x2c_t __attribute__((ext_vector_type(2)));
__device__ __forceinline__ unsigned cvtpk_c(float lo, float hi) { f32x2 v = {lo, hi}; bf16x2c_t b = __builtin_convertvector(v, bf16x2c_t); return __builtin_bit_cast(unsigned, b); }
template <int ACT> __device__ __forceinline__ bf16x8 act_frag(bf16x8 a) {
    float f[8];
#pragma unroll
    for (int e = 0; e < 8; ++e) { const float x = bf2f((unsigned short)a[e]); f[e] = ACT == 1 ? (2.f * sigm(2.f * x) - 1.f) : sigm(x); }
    u32x4 w; w.x = cvtpk_c(f[0], f[1]); w.y = cvtpk_c(f[2], f[3]); w.z = cvtpk_c(f[4], f[5]); w.w = cvtpk_c(f[6], f[7]);
    return __builtin_bit_cast(bf16x8, w);
}
__device__ __forceinline__ float hsum4(f32x4 v) { return (v.x + v.y) + (v.z + v.w); }
__device__ __forceinline__ void scan_phase(LAS unsigned char* lds, const ScanP& P, int G) {
    int tid_o_ = threadIdx.x; asm volatile("" : "+v"(tid_o_)); const int tid = tid_o_, lane = tid & 63, wave = __builtin_amdgcn_readfirstlane(tid >> 6);
    LAS float* ring = (LAS float*)lds;
    LAS float* ybuf = (LAS float*)(lds + 86016);
    constexpr int RB = 16 * 7 * 64;
    for (int item = blockIdx.x; item < NB * 16; item += G) {
        const int b = item >> 4, hd = item & 15; const size_t row0 = (size_t)b * S;
        if (wave < 4) {
            const int q = wave, p = lane & 7, rp = lane >> 3;
            f32x4 s0a = {0.f, 0.f, 0.f, 0.f}, s0b = s0a, s1a = s0a, s1b = s0a;
            __builtin_amdgcn_s_setprio(3);
            BAR_LDS();
            int cb = 0;
            for (int c = 0; c < S / 16; ++c) {
                const LAS float* rb = ring + cb * RB; LAS float* yb = ybuf + (c & 1) * 1024;
#define CLOAD(W_, A_, B_, K_, R_, V_, tt) do { const LAS float* bs_ = rb + (tt) * 448 + 8 * p; \
                    W_[0] = *(const LAS f32x4*)(bs_); W_[1] = *(const LAS f32x4*)(bs_ + 4); A_[0] = *(const LAS f32x4*)(bs_ + 64); A_[1] = *(const LAS f32x4*)(bs_ + 68); \
                    B_[0] = *(const LAS f32x4*)(bs_ + 128); B_[1] = *(const LAS f32x4*)(bs_ + 132); K_[0] = *(const LAS f32x4*)(bs_ + 192); K_[1] = *(const LAS f32x4*)(bs_ + 196); \
                    R_[0] = *(const LAS f32x4*)(bs_ + 256); R_[1] = *(const LAS f32x4*)(bs_ + 260); V_ = *(const LAS f32x2*)(rb + (tt) * 448 + 320 + 16 * q + 2 * rp); } while (0)
                f32x4 cw[2], ca[2], cbv[2], ck[2], cr[2]; f32x2 cv;
                CLOAD(cw, ca, cbv, ck, cr, cv, 0);
#pragma unroll
                for (int t = 0; t < 16; ++t) {
                    f32x4 nw[2], na[2], nbv[2], nk[2], nr[2]; f32x2 nv;
                    if (t < 15) CLOAD(nw, na, nbv, nk, nr, nv, t + 1);
                    float sa0 = hsum4(s0a * ca[0] + s0b * ca[1]), sa1 = hsum4(s1a * ca[0] + s1b * ca[1]);
                    sa0 = row8_sum(sa0); sa1 = row8_sum(sa1);
                    s0a = s0a * cw[0] + (cbv[0] * sa0 + ck[0] * cv.x); s0b = s0b * cw[1] + (cbv[1] * sa0 + ck[1] * cv.x);
                    s1a = s1a * cw[0] + (cbv[0] * sa1 + ck[0] * cv.y); s1b = s1b * cw[1] + (cbv[1] * sa1 + ck[1] * cv.y);
                    float y0 = hsum4(s0a * cr[0] + s0b * cr[1]), y1 = hsum4(s1a * cr[0] + s1b * cr[1]);
                    y0 = row8_sum(y0); y1 = row8_sum(y1);
                    if (p < 2) yb[t * 64 + 16 * q + 2 * rp + p] = p ? y1 : y0;
                    if (t < 15) {
#pragma unroll
                        for (int e = 0; e < 2; ++e) { cw[e] = nw[e]; ca[e] = na[e]; cbv[e] = nbv[e]; ck[e] = nk[e]; cr[e] = nr[e]; }
                        cv = nv; }
                }
#undef CLOAD
                BAR_LDS();
                cb = cb == 2 ? 0 : cb + 1;
            }
            __builtin_amdgcn_s_setprio(0);
        } else {
            const int j = wave - 4, fr = lane & 15, fq = lane >> 4;
            const int gch = hd * 64 + 16 * j + fr;
            const float w0c = P.w0[gch], a0c = P.a0[gch], v0c = P.vres ? P.v0[gch] : 0.f, kkc = P.kk[gch], kac = P.ka[gch];
            const f32x4 kk4 = *(const f32x4*)(P.kk + hd * 64 + 4 * fr);
            const f32x4 lnw4 = *(const f32x4*)(P.lnw + hd * 64 + 4 * fr), lnb4 = *(const f32x4*)(P.lnb + hd * 64 + 4 * fr), rk4 = *(const f32x4*)(P.rk + hd * 64 + 4 * fr);
            bf16x8 bfr[10];
#pragma unroll
            for (int i = 0; i < 10; ++i) bfr[i] = *(const bf16x8*)(P.LB + (size_t)gch * 320 + 32 * i + 8 * fq);
            bf16x8 afr[10]; unsigned short rr[4], kr[4], vr[4], vfr[4]; u32x2 k4[4];
#define SC_LOAD(cc) do { const size_t r0_ = row0 + 16 * (size_t)(cc); const bf16_t* lp_ = P.L + (r0_ + fr) * 512 + 8 * fq; \
                _Pragma("unroll") for (int i = 0; i < 10; ++i) afr[i] = *(const bf16x8*)(lp_ + 32 * i); \
                _Pragma("unroll") for (int i = 0; i < 4; ++i) { const size_t rw_ = (r0_ + 4 * fq + i) * D; rr[i] = P.R[rw_ + gch]; kr[i] = P.K[rw_ + gch]; vr[i] = P.V[rw_ + gch]; \
                    vfr[i] = P.vres ? P.VF[rw_ + gch] : (unsigned short)0; k4[i] = *(const u32x2*)(P.K + rw_ + hd * 64 + 4 * fr); } } while (0)
#define SC_PROC(nb) do { const f32x4 z_ = {0.f, 0.f, 0.f, 0.f}; \
                f32x4 wl = __builtin_amdgcn_mfma_f32_16x16x32_bf16(afr[0], bfr[0], z_, 0, 0, 0); wl = __builtin_amdgcn_mfma_f32_16x16x32_bf16(afr[1], bfr[1], wl, 0, 0, 0); \
                f32x4 al = __builtin_amdgcn_mfma_f32_16x16x32_bf16(afr[2], bfr[2], z_, 0, 0, 0); al = __builtin_amdgcn_mfma_f32_16x16x32_bf16(afr[3], bfr[3], al, 0, 0, 0); \
                f32x4 vl = __builtin_amdgcn_mfma_f32_16x16x32_bf16(afr[4], bfr[4], z_, 0, 0, 0); \
                f32x4 gl = __builtin_amdgcn_mfma_f32_16x16x32_bf16(afr[5], bfr[5], z_, 0, 0, 0); \
                _Pragma("unroll") for (int i = 6; i < 10; ++i) gl = __builtin_amdgcn_mfma_f32_16x16x32_bf16(afr[i], bfr[i], gl, 0, 0, 0); \
                _Pragma("unroll") for (int i = 0; i < 4; ++i) { \
                    const float e0 = __uint_as_float(k4[i].x << 16) * kk4.x, e1 = __uint_as_float(k4[i].x & 0xffff0000u) * kk4.y, e2 = __uint_as_float(k4[i].y << 16) * kk4.z, e3 = __uint_as_float(k4[i].y & 0xffff0000u) * kk4.w; \
                    const float ss = row16_sum((e0 * e0 + e1 * e1) + (e2 * e2 + e3 * e3)); const float rn = __builtin_amdgcn_rsqf(fmaxf(ss, 1e-24f));     \
                    const float r = bf2f(rr[i]), k = bf2f(kr[i]); float v = bf2f(vr[i]); \
                    const float dec = __expf(-0.6065306597126334f * sigm(w0c + wl[i])); const float a = sigm(a0c + al[i]); \
                    if (P.vres) { const float vg = sigm(v0c + vl[i]); v = v + (bf2f(vfr[i]) - v) * vg; } \
                    const float kkn = k * kkc * rn, kp = k * (1.f + (a - 1.f) * kac); \
                    LAS float* o_ = ring + ((nb) * 16 + 4 * fq + i) * 448 + 16 * j + fr; \
                    o_[0] = dec; o_[64] = -kkn; o_[128] = kkn * a; o_[192] = kp; o_[256] = r; o_[320] = v; o_[384] = gl[i]; } } while (0)
#define SC_POST(pc, pb) do { const int tk = 4 * j + fq; const LAS float* bs = ring + ((pb) * 16 + tk) * 448 + 4 * fr; \
                const f32x4 y = *(const LAS f32x4*)(ybuf + ((pc) & 1) * 1024 + tk * 64 + 4 * fr), kp = *(const LAS f32x4*)(bs + 192), r = *(const LAS f32x4*)(bs + 256), v = *(const LAS f32x4*)(bs + 320), g = *(const LAS f32x4*)(bs + 384); \
                const float s1 = row16_sum(hsum4(y)), s2 = row16_sum(hsum4(y * y)), s3 = row16_sum(hsum4(r * kp * rk4)); \
                const float mean = s1 * (1.f / 64.f), var = fmaxf(s2 * (1.f / 64.f) - mean * mean, 0.f), rstd = rsqrtf(var + 64e-5f); \
                const f32x4 o = ((y - mean) * rstd * lnw4 + lnb4 + v * s3) * g; \
                u32x2 w_; w_.x = cvt_pk_bf16(o[0], o[1]); w_.y = cvt_pk_bf16(o[2], o[3]); \
                *(u32x2*)(P.Y + (row0 + 16 * (size_t)(pc) + tk) * D + hd * 64 + 4 * fr) = w_; } while (0)
            SC_LOAD(0); SC_PROC(0); SC_LOAD(1);
            BAR_LDS();
            int cb = 0;
            for (int c = 0; c < S / 16; ++c) {
                const int nb = cb == 2 ? 0 : cb + 1, pb = cb == 0 ? 2 : cb - 1;
                if (c + 1 < S / 16) SC_PROC(nb);
                if (c + 2 < S / 16) SC_LOAD(c + 2);
                if (c >= 1) SC_POST(c - 1, pb);
                BAR_LDS();
                cb = nb;
            }
            { const int pb = cb == 0 ? 2 : cb - 1; SC_POST(S / 16 - 1, pb); }
#undef SC_LOAD
#undef SC_PROC
#undef SC_POST
        }
        BAR_LDS();
    }
}

#define XB_TMO      128
#define XB_XCNT(j)  (256  + 64 * (j))
#define XB_XSUB(j)  (1280 + 64 * (j))
#define XB_XGEN(j)  (2304 + 64 * (j))
#define XB_TOP      3328
#define XB_TOPGEN   3392
#define XCD_BAR_WORDS 3456
#define XB_SPIN_CAP (1u << 18)

__device__ __forceinline__ unsigned xb_ld(unsigned* p)              { return __hip_atomic_load(p, __ATOMIC_RELAXED, __HIP_MEMORY_SCOPE_AGENT); }
__device__ __forceinline__ unsigned xb_add(unsigned* p, unsigned v) { return __hip_atomic_fetch_add(p, v, __ATOMIC_RELAXED, __HIP_MEMORY_SCOPE_AGENT); }
__device__ __forceinline__ unsigned xb_xcc_id() { return (unsigned)__builtin_amdgcn_s_getreg((3 << 11) | 20) & 0xFu; }
#define XB_SPIN(cond, bar) do { unsigned _sp = 0; while (cond) { __builtin_amdgcn_s_sleep(1); \
    if ((++_sp & 255u) == 0u) { if (xb_ld(&(bar)[XB_TMO])) break; if (_sp > XB_SPIN_CAP) { atomicAdd(&(bar)[XB_TMO], 1u); break; } } } } while (0)

struct XcdBarrier {
    unsigned* bar; unsigned x;
    volatile LAS unsigned* st;
};

__device__ __forceinline__ XcdBarrier xcd_barrier_post(unsigned* bar, volatile LAS unsigned* st) {
    XcdBarrier b; b.bar = bar; b.x = xb_xcc_id(); b.st = st;
    if (threadIdx.x == 0) (void)xb_add(&bar[XB_XCNT(b.x)], 1u);
    return b;
}
__device__ __forceinline__ void xcd_barrier_complete(unsigned* bar, unsigned x, unsigned& nloc, unsigned& nx) {
    const unsigned G = gridDim.x * gridDim.y * gridDim.z;
    unsigned sum, cnt, mine, sp = 0u;
    for (;;) {
        sum = 0u; cnt = 0u; mine = 0u;
#pragma unroll
        for (unsigned j = 0; j < 16; ++j) { const unsigned c = xb_ld(&bar[XB_XCNT(j)]); sum += c; cnt += (c > 0u) ? 1u : 0u; mine = (j == x) ? c : mine; }
        if (sum == G) break;
        __builtin_amdgcn_s_sleep(1);
        if ((++sp & 255u) == 0u) { if (xb_ld(&bar[XB_TMO])) break; if (sp > XB_SPIN_CAP) { atomicAdd(&bar[XB_TMO], 1u); break; } }
    }
    nloc = mine > 0u ? mine : 1u; nx = cnt > 0u ? cnt : 1u;
}

__device__ __forceinline__ void xcd_barrier(const XcdBarrier& b) {
    asm volatile("s_waitcnt vmcnt(0)" ::: "memory");
    __syncthreads();
    if (threadIdx.x == 0) {
        unsigned* bar = b.bar;
        __builtin_amdgcn_s_waitcnt(0);
        unsigned nloc = b.st[0], nx = b.st[1];
        if (nloc == 0u) { xcd_barrier_complete(bar, b.x, nloc, nx); b.st[0] = nloc; b.st[1] = nx; }
        const unsigned old = xb_add(&bar[XB_XSUB(b.x)], 1u);
        const unsigned gen = old / nloc;
        if (old + 1u == (gen + 1u) * nloc) {
            __builtin_amdgcn_fence(__ATOMIC_RELEASE, "agent");
            asm volatile("s_waitcnt vmcnt(0)" ::: "memory");
            const unsigned og = xb_add(&bar[XB_TOP], 1u);
            const unsigned tg = og / nx;
            if (og + 1u == (tg + 1u) * nx) xb_add(&bar[XB_TOPGEN], 1u);
            else XB_SPIN(xb_ld(&bar[XB_TOPGEN]) == tg, bar);
            __builtin_amdgcn_fence(__ATOMIC_ACQUIRE, "agent");
            xb_add(&bar[XB_XGEN(b.x)], 1u);
            asm volatile("s_waitcnt vmcnt(0)" ::: "memory");
        } else {
            XB_SPIN(xb_ld(&bar[XB_XGEN(b.x)]) == gen, bar);
            __builtin_amdgcn_fence(__ATOMIC_ACQUIRE, "agent");
            asm volatile("s_waitcnt vmcnt(0)" ::: "memory");
        }
    }
    __syncthreads();
}

struct Args { const float* in[36]; float* out; unsigned char* ws; };
#ifndef DBG
#define DBG 0
#endif
__device__ __forceinline__ void dbg_dump(float* out, const bf16_t* A, const bf16_t* B, const bf16_t* C, const bf16_t* L, int g0, int gn) {
    for (size_t i = g0; i < (size_t)T * D; i += gn) { float s = 0.f; if (A) s += bf2f(A[i]); if (B) s += bf2f(B[i]); if (C) s += bf2f(C[i]); if (L) s += bf2f(L[(i >> 10) * 512 + (i & 511)]); out[i] = s; }
}
enum { I_X = 0, I_C, I_ADAW, I_ADAB, I_N1, I_N2, I_FN, I_MU, I_WRKV, I_W0, I_W1, I_W2, I_A0, I_A1, I_A2, I_V0, I_V1, I_V2, I_G1, I_G2, I_KK, I_KA, I_RK, I_LNW, I_LNB, I_WOA,
       I_KVN, I_WKV, I_WQ, I_LAM, I_SUBLN, I_WOB, I_UP, I_CW, I_CB, I_DN };

__global__ void __launch_bounds__(NTHR, 2) yoco_fwd(Args a) {
    extern __shared__ __attribute__((aligned(16))) unsigned char lds_raw[];
    LAS unsigned char* lds = (LAS unsigned char*)lds_raw;
    cg::grid_group grid = cg::this_grid();
#define OPQ(x) ({ int o_ = (x); asm volatile("" : "+s"(o_)); o_; })
#define TIDX() ({ int t_ = threadIdx.x; asm volatile("" : "+v"(t_)); t_; })
#define tid TIDX()
#define lane (TIDX() & 63)
#define gtid (bx * NTHR + TIDX())
    const int wave = __builtin_amdgcn_readfirstlane((int)threadIdx.x >> 6);
    const int G = gridDim.x, bx = blockIdx.x, gw = bx * NWAVES + wave, NGW = G * NWAVES, NTOT = G * NTHR;
    unsigned char* ws = a.ws;
    LAS unsigned long long* ptab = (LAS unsigned long long*)(lds + 131072);
    if (tid == 0) {
#pragma unroll
        for (int i = 0; i < 36; ++i) ptab[i] = (unsigned long long)(uintptr_t)a.in[i]; }
    if (TIDX() < 64) ((LAS unsigned*)(lds + 131072 + 512))[TIDX()] = 0u;
    __syncthreads();
    grid.sync();
    (void)xcd_barrier_post((unsigned*)(ws + WS_CTL), (volatile LAS unsigned*)(lds + 131072 + 512) + 8);
#define PTABW(i) ({ unsigned o_ = 131072u + 8u * (unsigned)(i); asm volatile("" : "+v"(o_)); *(LAS unsigned long long*)o_; })
#define INP(i) ({ const unsigned long long w_ = PTABW(i); (const float*)(uintptr_t)(((unsigned long long)(unsigned)__builtin_amdgcn_readfirstlane((int)(w_ >> 32)) << 32) | (unsigned long long)(unsigned)__builtin_amdgcn_readfirstlane((int)(unsigned)w_)); })
    bf16_t* Wb = (bf16_t*)(ws + WS_W); bf16_t* H = (bf16_t*)(ws + WS_H);
    float* MOD = (float*)(ws + WS_MOD); float* ROPE = (float*)(ws + WS_ROPE); float* MODP = (float*)(ws + WS_MODP);
    float* out = a.out;
#define SYNC() do { XcdBarrier b_; b_.bar = (unsigned*)(ws + WS_CTL); b_.x = xb_xcc_id(); b_.st = (volatile LAS unsigned*)(lds + 131072 + 512) + 8; xcd_barrier(b_); } while (0)

    {
        LAS float* cact = (LAS float*)(lds + 69632);
        for (int i = tid; i < NB * D; i += NTHR) { const float c = INP(I_C)[i]; cact[(i & (D - 1)) * 8 + (i >> 10)] = c / (1.f + expf(-c)); }
        __syncthreads();
        for (int i = gtid; i < NB * 8 * 128; i += NTOT) { const int b = i >> 10, r = (i >> 7) & 7, c8 = i & 127; *(u32x4*)(H + ((size_t)b * SP + r) * D + 8 * c8) = (u32x4){0u, 0u, 0u, 0u}; }
        for (int i = gtid; i < S * 8; i += NTOT) { const float ang = (float)(i >> 3) * rope_inv(i & 7); ROPE[i] = cosf(ang); ROPE[S * 8 + i] = sinf(ang); }
        for (int it = gw; it < 4 * 24 * 32; it += NGW) {
            const int ks = it & 31, cc = (it >> 5) % 24, l = it / (32 * 24);
            f32x4 acc[8];
#pragma unroll
            for (int b = 0; b < 8; ++b) acc[b] = (f32x4){0.f, 0.f, 0.f, 0.f};
            const float* wp = INP(I_ADAW) + ((size_t)l * D + 32 * ks) * 6144 + 256 * cc + 4 * lane;
#pragma unroll 8
            for (int kk = 0; kk < 32; ++kk) { const f32x4 w = *(const f32x4*)(wp + (size_t)kk * 6144); const LAS float* cp = cact + (32 * ks + kk) * 8;
                const f32x4 c0 = *(const LAS f32x4*)cp, c1 = *(const LAS f32x4*)(cp + 4);
                acc[0] += w * c0.x; acc[1] += w * c0.y; acc[2] += w * c0.z; acc[3] += w * c0.w; acc[4] += w * c1.x; acc[5] += w * c1.y; acc[6] += w * c1.z; acc[7] += w * c1.w; }
#pragma unroll
            for (int b = 0; b < 8; ++b) *(f32x4*)(MODP + ((size_t)(ks * 4 + l) * 8 + b) * 6144 + 256 * cc + 4 * lane) = acc[b];
        }
        LAS Job* jobs = (LAS Job*)(lds + 102400); int nj = 0, tot = 0;
#define ADDJOB(W_, mu_, Bt_, ldw_, K_, N_, ldb_, kdst0_, mode_, map_, rowoff_) do { if (tid == 0) { LAS Job* jb = jobs + nj; jb->W = (W_); jb->mu = (mu_); jb->Bt = (Bt_); jb->ldw = (ldw_); jb->K = (K_); jb->N = (N_); \
            jb->ldb = (ldb_); jb->kdst0 = (kdst0_); jb->mode = (mode_); jb->map = (map_); jb->rowoff = (rowoff_); jb->start = tot; } tot += ((K_) / 64) * ((N_) / 32); ++nj; asm volatile("" ::: "memory"); } while (0)
        for (int l = 0; l < 2; ++l) {
            const float* mu = INP(I_MU) + (size_t)l * 6 * D; bf16_t* B = Wb + we_rkvl(l);
            for (int i = 0; i < 3; ++i) { const float* W = INP(I_WRKV) + (size_t)(l * 3 + i) * D * D; const float* m = mu + (i == 0 ? 0 : (i == 1 ? 2 : 3)) * D;
                ADDJOB(W, m, B, D, D, D, 2048, 0, 1, 0, i * D); ADDJOB(W, m, B, D, D, D, 2048, D, 2, 0, i * D); }
            ADDJOB(INP(I_W1) + (size_t)l * D * 64, mu + 1 * D, B, 64, D, 64, 2048, 0, 1, 0, 3072); ADDJOB(INP(I_W1) + (size_t)l * D * 64, mu + 1 * D, B, 64, D, 64, 2048, D, 2, 0, 3072);
            ADDJOB(INP(I_A1) + (size_t)l * D * 64, mu + 4 * D, B, 64, D, 64, 2048, 0, 1, 0, 3136); ADDJOB(INP(I_A1) + (size_t)l * D * 64, mu + 4 * D, B, 64, D, 64, 2048, D, 2, 0, 3136);
            if (l == 1) { ADDJOB(INP(I_V1), mu + 3 * D, B, 32, D, 32, 2048, 0, 1, 0, 3200); ADDJOB(INP(I_V1), mu + 3 * D, B, 32, D, 32, 2048, D, 2, 0, 3200); }
            ADDJOB(INP(I_G1) + (size_t)l * D * 160, mu + 5 * D, B, 160, D, 160, 2048, 0, 1, 0, 3232); ADDJOB(INP(I_G1) + (size_t)l * D * 160, mu + 5 * D, B, 160, D, 160, 2048, D, 2, 0, 3232);
            ADDJOB(INP(I_WOA) + (size_t)l * D * D, nullptr, Wb + we_woa(l), D, D, D, D, 0, 0, 0, 0);
        }
        for (int l = 0; l < 4; ++l) {
            ADDJOB(INP(I_UP) + (size_t)l * D * FF2, nullptr, Wb + we_up(l), FF2, D, FF2, D, 0, 0, 1, 0);
            ADDJOB(INP(I_DN) + (size_t)l * FF * D, nullptr, Wb + we_dn(l), D, FF, D, FF, 0, 0, 0, 0);
        }
        ADDJOB(INP(I_WKV), nullptr, Wb + WE_KV, 2048, D, D, D, 0, 0, 2, 0); ADDJOB(INP(I_WKV) + D, nullptr, Wb + WE_KV, 2048, D, D, D, 0, 0, 0, D);
        for (int j = 0; j < 2; ++j) { ADDJOB(INP(I_WQ) + (size_t)j * D * D, nullptr, Wb + we_q(j), D, D, D, D, 0, 0, 2, 0); ADDJOB(INP(I_WOB) + (size_t)j * D * D, nullptr, Wb + we_ob(j), D, D, D, D, 0, 0, 0, 0); }
#undef ADDJOB
        __syncthreads();
        LAS float* scr = (LAS float*)(lds + wave * 8704); int jn = 0;
        {
            float va[32], vb[32]; int it = gw, jc = 0, ic = 0;
            if (it < tot) { while (jn + 1 < nj && jobs[jn + 1].start <= it) ++jn; jc = jn; ic = it - jobs[jn].start; tr_load(jobs + jc, ic, va, lane); }
            while (it < tot) {
                int it2 = it + NGW, j2 = jc, i2 = 0;
                if (it2 < tot) { while (jn + 1 < nj && jobs[jn + 1].start <= it2) ++jn; j2 = jn; i2 = it2 - jobs[jn].start; tr_load(jobs + j2, i2, vb, lane); }
                tr_store(jobs + jc, ic, va, scr, lane);
                it = it2 + NGW; jc = j2; ic = i2;
                if (it2 >= tot) break;
                int j3 = jc, i3 = 0;
                if (it < tot) { while (jn + 1 < nj && jobs[jn + 1].start <= it) ++jn; j3 = jn; i3 = it - jobs[jn].start; tr_load(jobs + j3, i3, va, lane); }
                tr_store(jobs + jc, ic, vb, scr, lane);
                jc = j3; ic = i3;
            }
        }
        for (int i = gtid; i < 2 * 40 * D; i += NTOT) { const int l = i / (40 * D), r = i % (40 * D), kg = r >> 10, n = r & (D - 1), k = 8 * kg;
            const float* src = nullptr;
            if (k < 64) src = INP(I_W2) + ((size_t)l * 64 + k) * D; else if (k < 128) src = INP(I_A2) + ((size_t)l * 64 + (k - 64)) * D;
            else if (k < 160) src = (l == 1) ? INP(I_V2) + (size_t)(k - 128) * D : nullptr; else src = INP(I_G2) + ((size_t)l * 160 + (k - 160)) * D;
            float f[8];
#pragma unroll
            for (int e = 0; e < 8; ++e) f[e] = src ? src[(size_t)e * D + n] : 0.f;
            u32x4 w; w.x = cvt_pk_bf16(f[0], f[1]); w.y = cvt_pk_bf16(f[2], f[3]); w.z = cvt_pk_bf16(f[4], f[5]); w.w = cvt_pk_bf16(f[6], f[7]);
            *(u32x4*)(Wb + we_lb(l) + (size_t)n * 320 + k) = w; }
    }
    SYNC();
    {
        for (int i = gtid; i < 4 * 8 * 6144; i += NTOT) { const int n = i % 6144, l = i / (8 * 6144); float s = INP(I_ADAB)[l * 6144 + n];
#pragma unroll 8
            for (int ks = 0; ks < 32; ++ks) s += MODP[(size_t)ks * (4 * 8 * 6144) + i];
            MOD[i] = s; }
    }
    SYNC();

#define BIAS_WORK(W0_, NW_) do { \
                for (int i = (W0_) * 64 + lane; i < D; i += (NW_) * 64) ((float*)(ws + WS_KVNC))[i] = INP(I_KVN)[i]; \
                for (int rw = (W0_); rw < 4 * FF2 + 2 * D; rw += (NW_)) { \
                    const bool up = rw < 4 * FF2; const int jq = up ? 0 : (rw - 4 * FF2) / D; const int lw = up ? rw / FF2 : 2 + jq, r = up ? rw % FF2 : (rw - 4 * FF2) % D; \
                    const bf16_t* Brow = (up ? Wb + we_up(lw) : Wb + we_q(jq)) + (size_t)r * D + 16 * lane; \
                    const float* shp = MOD + (size_t)lw * 8 * 6144 + (up ? 3072 : 0) + 16 * lane; \
                    float* dst = up ? (float*)(ws + WS_BIASUP) + (size_t)lw * 8 * FF2 + r : (float*)(ws + WS_BIASQ) + (size_t)jq * 8 * D + r; const int dstr = up ? FF2 : D; \
                    const u32x4 w0 = *(const u32x4*)Brow, w1 = *(const u32x4*)(Brow + 8); float wv[16]; \
_Pragma("unroll") \
                    for (int e = 0; e < 4; ++e) { wv[2 * e] = __uint_as_float(w0[e] << 16); wv[2 * e + 1] = __uint_as_float(w0[e] & 0xffff0000u); wv[8 + 2 * e] = __uint_as_float(w1[e] << 16); wv[9 + 2 * e] = __uint_as_float(w1[e] & 0xffff0000u); } \
                    for (int b = 0; b < 8; ++b) { float sacc = 0.f; \
_Pragma("unroll") \
                        for (int e = 0; e < 4; ++e) { const f32x4 sv = *(const f32x4*)(shp + (size_t)b * 6144 + 4 * e); sacc += (wv[4 * e] * sv[0] + wv[4 * e + 1] * sv[1]) + (wv[4 * e + 2] * sv[2] + wv[4 * e + 3] * sv[3]); } \
                        sacc = wave_sum_dpp(sacc); if (lane == 0) dst[(size_t)b * dstr] = sacc; } \
                } \
} while (0)
    for (int l = 0; l < 4; ++l) {
        const float* xin = (l == 0) ? INP(I_X) : out;
        const float* modl = MOD + (size_t)l * 8 * 6144;
        if (l < 2) {
            norm_phase(xin, INP(I_N1) + (size_t)l * D, modl, 0, 1024, H, nullptr, nullptr, gw, NGW, lane);
            if (l == 0) {
                if (G <= NB * 16) BIAS_WORK(gw, NGW);
            }
            SYNC();
        }
        bf16_t* mixo;
        if (l < 2) {
            bf16_t* Rb = (bf16_t*)(ws + WS_R); bf16_t* Kb = (bf16_t*)(ws + WS_K); bf16_t* Vb = (bf16_t*)(ws + (l == 0 ? WS_VF : WS_V1)); bf16_t* Lb = (bf16_t*)(ws + WS_L);
            {
                pg8::Gemm g; g.A = (const char*)(H + (size_t)8 * D); g.Bt = Wb + we_rkvl(l); g.K = 2048; g.lda = D;
                pg8::StaticOrder So; So.init(T / 256, (int)NRKVL / 256, OPQ(G), OPQ(bx));
                EpiRkvL E{Rb, Kb, Vb, Lb};
                pg8::gemm_phase<EpiRkvL, pg8::StaticOrder, true, true, 16, false, true>(lds, g, So, E);
            }
            SYNC();
            if (DBG == 1) { dbg_dump(out, Rb, Kb, Vb, Lb, gtid, NTOT); return; }
            {
                ScanP P; P.R = Rb; P.K = Kb; P.V = Vb; P.VF = (const bf16_t*)(ws + WS_VF); P.L = Lb; P.Y = Rb; P.LB = Wb + we_lb(l);
                P.w0 = INP(I_W0) + (size_t)l * D; P.a0 = INP(I_A0) + (size_t)l * D; P.v0 = INP(I_V0); P.kk = INP(I_KK) + (size_t)l * D; P.ka = INP(I_KA) + (size_t)l * D;
                P.rk = INP(I_RK) + (size_t)l * D; P.lnw = INP(I_LNW) + (size_t)l * D; P.lnb = INP(I_LNB) + (size_t)l * D; P.vres = (l == 1);
                scan_phase(lds, P, OPQ(G));
                if (l == 0 && OPQ(G) > NB * 16 && OPQ(bx) >= NB * 16) BIAS_WORK((bx - NB * 16) * NWAVES + wave, (G - NB * 16) * NWAVES);
            }
            mixo = Rb;
            if (DBG == 2) { SYNC(); return; }
        } else {
            const int j = l - 2;
            bf16_t* Qb = (bf16_t*)(ws + WS_Q); bf16_t* KSb = (bf16_t*)(ws + WS_KS); bf16_t* VSb = (bf16_t*)(ws + WS_VS); bf16_t* O0 = (bf16_t*)(ws + WS_O0); bf16_t* O1 = (bf16_t*)(ws + WS_O1);
            for (int gi = 0; gi < (j == 0 ? 2 : 1); ++gi) {
                pg8::Gemm g; g.A = (const char*)((gi == 0 ? H : (bf16_t*)(ws + WS_HK)) + (size_t)8 * D); g.Bt = gi == 0 ? Wb + we_q(j) : Wb + WE_KV; g.K = D; g.lda = D;
                pg8::StaticOrder So; So.init(T / 256, gi == 0 ? 4 : 8, OPQ(G), OPQ(bx));
                EpiRope E{ws, (unsigned)(gi == 0 ? WS_Q : WS_KS), (unsigned)WS_VS, (unsigned)(WS_SS + (l == 3 ? 4 : 5) * (size_t)T * 4), (unsigned)(WS_BIASQ + (size_t)j * 8 * D * 4), gi == 0 ? attn_body::C2 : 1.f, 1, gi == 0 ? 1 : 0};
                pg8::gemm_phase<EpiRope, pg8::StaticOrder, true, true, 16, false, false>(lds, g, So, E);
            }
            SYNC();
            {
                const int G_ = OPQ(G), bx_ = OPQ(bx); const int vcu = (G_ % 8 == 0) ? (bx_ % 8) * (G_ / 8) + bx_ / 8 : bx_;
                for (int combo = vcu; combo < 256; combo += G_) { const int b = combo >> 5, vhd = (combo >> 1) & 15, vh = combo & 1;
                    for (int qb = S / 256 - 1; qb >= 0; --qb)
                        attn_body::attn_unit<8>(b, vhd * 64, (vhd >> 1) * 128 + vh * 64, qb, (const attn_body::bf16*)Qb, (const attn_body::bf16*)KSb, (const attn_body::bf16*)VSb, (attn_body::bf16*)((vhd & 1) ? O1 : O0), (char*)lds_raw); }
            }
            SYNC();
            combine_phase(O0, O1, INP(I_LAM) + (size_t)j * 256, INP(I_SUBLN) + (size_t)j * 128, 0.8f - 0.6f * expf(-0.3f * (float)l), gw, NGW, lane);
            mixo = O0;
        }
        SYNC();
        for (int pass = 0; pass < 2; ++pass) {
            const size_t act_off = l == 0 ? WS_ACT_R : (l == 1 ? WS_A : WS_ACT_B);
            bf16_t* ACT = (bf16_t*)(ws + act_off);
            if (pass) {
                {
                    pg8::Gemm g; g.A = (const char*)(H + (size_t)6 * D); g.Bt = Wb + we_up(l); g.K = D; g.lda = D;
                    pg8::StaticOrder So; So.init(NB * 17, FF2 / 256, OPQ(G), OPQ(bx));
                    EpiUp E{ws, INP(I_CW) + (size_t)l * 3 * FF2, INP(I_CB) + (size_t)l * FF2, (unsigned)act_off, (unsigned)(WS_SS + (size_t)l * T * 4), (unsigned)(WS_BIASUP + (size_t)l * 8 * FF2 * 4)};
                    pg8::gemm_phase<EpiUp, pg8::StaticOrder, true, true, 17, true, false>(lds, g, So, E);
                }
                SYNC();
                if (DBG == 4) { for (size_t i = gtid; i < (size_t)T * D; i += NTOT) out[i] = bf2f(ACT[(i >> 10) * FF + (i & 1023)]) + bf2f(ACT[(i >> 10) * FF + 1024 + (i & 1023)]) + bf2f(ACT[(i >> 10) * FF + 1792 + (i & 1023)]); return; }
            }
            {
                pg8::Gemm g; g.A = (const char*)(pass ? ACT : mixo); g.Bt = pass ? Wb + we_dn(l) : (l < 2 ? Wb + we_woa(l) : Wb + we_ob(l - 2)); g.K = pass ? FF : D; g.lda = g.K;
                pg8::StaticOrder So; So.init(T / 256, 4, OPQ(G), OPQ(bx));
                const int nx = pass == 0 ? 1 : (l == 1 ? 2 : (l == 2 ? 1 : 0));
                EpiRes E{(l == 0 && pass == 0) ? INP(I_X) : out, out, ws, pass == 0 ? INP(I_N2) + (size_t)l * D : INP(I_N1) + (size_t)(l + 1 < 4 ? l + 1 : 3) * D, (unsigned)(WS_MOD + ((size_t)l * 8 * 6144 + (pass ? 5120 : 2048)) * 4),
                         (unsigned)(WS_MOD + (pass == 0 ? (size_t)l * 8 * 6144 + 4096 : (size_t)(l + 1 < 4 ? l + 1 : 3) * 8 * 6144 + 1024) * 4), (unsigned)(WS_SS + (pass == 0 ? (size_t)l : (l == 2 ? (size_t)4 : (size_t)5)) * T * 4), nx};
                pg8::gemm_phase<EpiRes, pg8::StaticOrder, true, true, 0, false, false>(lds, g, So, E);
            }
            SYNC();
            if (DBG == 3 && pass == 0) return;
            if (DBG == 5 && pass == 1) return;
            if (DBG == 6 && pass == 1 && l == 1) return;
            if (DBG == 7 && pass == 1 && l == 2) return;
        }
    }
    final_norm_phase(out, INP(I_FN), gw, NGW, lane);
#undef tid
#undef lane
#undef gtid
}

extern "C" void kernel_launch(void* const* d_in, const int* in_sizes, int n_in, void* d_out, int out_size, void* d_ws, size_t ws_size, hipStream_t stream) {
    static int grid = 0;
    if (grid == 0) {
        if (n_in != 36 || out_size != T * D || ws_size < WS_END) { fprintf(stderr, "kernel_launch: unexpected problem (n_in %d, out %d, ws %zu < %zu)\n", n_in, out_size, ws_size, (size_t)WS_END); grid = -1; return; }
        int dev = 0, cus = 0, per_cu = 0;
        hipGetDevice(&dev); hipDeviceGetAttribute(&cus, hipDeviceAttributeMultiprocessorCount, dev);
        if (hipFuncSetAttribute((const void*)yoco_fwd, hipFuncAttributeMaxDynamicSharedMemorySize, LDS_BYTES) != hipSuccess) { fprintf(stderr, "kernel_launch: hipFuncSetAttribute failed\n"); grid = -1; return; }
        if (hipOccupancyMaxActiveBlocksPerMultiprocessor(&per_cu, (const void*)yoco_fwd, NTHR, LDS_BYTES) != hipSuccess || per_cu < 1) { fprintf(stderr, "kernel_launch: occupancy query failed (%d)\n", per_cu); (void)hipGetLastError(); per_cu = 1; }
        grid = cus * per_cu;
    }
    if (grid < 0) return;
    if (hipMemsetAsync((char*)d_ws + WS_CTL, 0, 1048576, stream) != hipSuccess) { fprintf(stderr, "kernel_launch: memset failed\n"); return; }
    Args a{};
    for (int i = 0; i < 36; ++i) a.in[i] = (const float*)d_in[i];
    a.out = (float*)d_out; a.ws = (unsigned char*)d_ws;
    void* args[] = {&a};
    hipError_t e = hipLaunchCooperativeKernel((const void*)yoco_fwd, dim3(grid), dim3(NTHR), args, LDS_BYTES, stream);
    if (e != hipSuccess) fprintf(stderr, "kernel_launch: cooperative launch failed: %s (grid %d)\n", hipGetErrorString(e), grid);
}
```
